# Optimizing an MI355X kernel written in HIP

```python
import math
import jax
import jax.numpy as jnp
from jax import lax
import numpy as np

D_MODEL = 1024
BATCH = 4
SEQ = 8192
DEPTH = 2

N_EVEN = (DEPTH + 1) // 2
N_ODD = DEPTH // 2
NORM_EPS = 1e-6
NEG_INF = -1e30
FORCED_SCORE = 1e9

NSA_HEADS = 8
NSA_KV_GROUPS = 2
NSA_HEAD_DIM = 64
NSA_Q_PER_GROUP = NSA_HEADS // NSA_KV_GROUPS
CMP_BLOCK = 32
CMP_STRIDE = 16
SLC_BLOCK = 64
SLC_TOPK = 16
WINDOW = 512
Q_BLOCK = 128
ROPE_THETA = 500000.0
ROT_DIM = NSA_HEAD_DIM // 4

SSD_HEADS = 8
SSD_HEAD_DIM = 64
SSD_INNER = SSD_HEADS * SSD_HEAD_DIM
SSD_GROUPS = 2
SSD_STATE = 128
SSD_CONV = 4
SSD_CHUNK = 256
SSD_CONV_DIM = SSD_INNER + 2 * SSD_GROUPS * SSD_STATE

NSA_Q_W = NSA_HEADS * NSA_HEAD_DIM
NSA_KV_W = NSA_KV_GROUPS * NSA_HEAD_DIM
NSA_GATE_W = NSA_HEADS * 3
HY_SPLITS = (NSA_Q_W, 6 * NSA_KV_W, NSA_GATE_W, SSD_INNER, SSD_CONV_DIM, SSD_HEADS)
HY_IN_W = sum(HY_SPLITS)
HY_MIX_W = NSA_Q_W + SSD_INNER

GDN_HEADS = 8
GDN_DK = 128
GDN_DV = 128
GDN_CONV = 4
GDN_CHUNK = 64
GDN_QK_W = GDN_HEADS * GDN_DK
GDN_V_W = GDN_HEADS * GDN_DV
GDN_CONV_DIM = 2 * GDN_QK_W + GDN_V_W
GDN_SPLITS = (GDN_CONV_DIM, GDN_V_W, GDN_HEADS, GDN_HEADS)
GDN_IN_W = sum(GDN_SPLITS)

FFN_DIM = 2816
FFN_CONV = 3

kernel_name = 'hybrid_nsa_ssd_gdn_convffn'


def split_last(t, sizes):
    return jnp.split(t, np.cumsum(sizes)[:-1].tolist(), axis=-1)


def rms_norm(x, g):
    xf = x.astype(jnp.float32)
    y = xf * lax.rsqrt(jnp.mean(xf * xf, axis=-1, keepdims=True) + NORM_EPS)
    return (y * g.astype(jnp.float32)).astype(x.dtype)


def l2_norm(x):
    xf = x.astype(jnp.float32)
    return (xf * lax.rsqrt(jnp.sum(xf * xf, axis=-1, keepdims=True) + NORM_EPS)).astype(x.dtype)


def causal_dwconv(x, w, b=None):
    width = w.shape[0]
    seq = x.shape[1]
    xp = jnp.pad(x, ((0, 0), (width - 1, 0), (0, 0)))
    y = xp[:, 0:seq] * w[0]
    for j in range(1, width):
        y = y + xp[:, j:j + seq] * w[j]
    return y if b is None else y + b


def masked_softmax(s, mask):
    p = jax.nn.softmax(jnp.where(mask, s.astype(jnp.float32), NEG_INF), axis=-1)
    return jnp.where(mask, p, 0.0)


def partial_rope(x, positions):
    inv_freq = ROPE_THETA ** (-jnp.arange(0, ROT_DIM, 2, dtype=jnp.float32) / ROT_DIM)
    ang = positions.astype(jnp.float32)[..., None] * inv_freq
    cos = jnp.cos(ang)[:, :, None, :]
    sin = jnp.sin(ang)[:, :, None, :]
    half = ROT_DIM // 2
    xr = x[..., :ROT_DIM].astype(jnp.float32)
    x1, x2 = xr[..., :half], xr[..., half:]
    rot = jnp.concatenate([x1 * cos - x2 * sin, x2 * cos + x1 * sin], axis=-1).astype(x.dtype)
    return jnp.concatenate([rot, x[..., ROT_DIM:]], axis=-1)


def nsa_attention(q, k_cmp, v_cmp, k_slc, v_slc, k_win, v_win, gates,
                  pe_k, pe_v, ck_w1, ck_b1, ck_w2, cv_w1, cv_b1, cv_w2):
    bsz, seq = q.shape[0], q.shape[1]
    grp, rep, dh = NSA_KV_GROUPS, NSA_Q_PER_GROUP, NSA_HEAD_DIM
    scale = dh ** -0.5
    q = q.reshape(bsz, seq, grp, rep, dh).transpose(0, 2, 3, 1, 4)
    gates = gates.reshape(bsz, seq, grp, rep, 3).transpose(0, 2, 3, 1, 4)
    k_cmp, v_cmp, k_slc, v_slc, k_win, v_win = [
        t.transpose(0, 2, 1, 3) for t in (k_cmp, v_cmp, k_slc, v_slc, k_win, v_win)]

    n_cmp = (seq - CMP_BLOCK) // CMP_STRIDE + 1
    idx = np.arange(n_cmp)[:, None] * CMP_STRIDE + np.arange(CMP_BLOCK)[None, :]
    cmp_end = jnp.asarray(idx[:, -1])

    def compress(t, pe, w1, b1, w2):
        blocks = t[:, :, idx] + pe
        hid = jax.nn.silu(blocks.reshape(bsz, grp, n_cmp, CMP_BLOCK * dh) @ w1 + b1)
        return hid @ w2

    kc = compress(k_cmp, pe_k, ck_w1, ck_b1, ck_w2)
    vc = compress(v_cmp, pe_v, cv_w1, cv_b1, cv_w2)

    n_slc = seq // SLC_BLOCK
    top = min(SLC_TOPK, n_slc)
    cs = np.arange(n_cmp) * CMP_STRIDE
    ss = np.arange(n_slc) * SLC_BLOCK
    overlap = jnp.asarray(((cs[:, None] <= ss[None, :] + SLC_BLOCK - 1)
                           & (cs[:, None] + CMP_BLOCK - 1 >= ss[None, :])).astype(np.float32))
    blk = jnp.arange(n_slc)
    gather = jax.vmap(jax.vmap(lambda kk, ii: kk[ii]))

    kwp = jnp.pad(k_win, ((0, 0), (0, 0), (WINDOW, 0), (0, 0)))
    vwp = jnp.pad(v_win, ((0, 0), (0, 0), (WINDOW, 0), (0, 0)))

    def block_fn(i):
        t0 = i * Q_BLOCK
        tpos = t0 + jnp.arange(Q_BLOCK)
        qb = lax.dynamic_slice_in_dim(q, t0, Q_BLOCK, axis=3)
        gb = lax.dynamic_slice_in_dim(gates, t0, Q_BLOCK, axis=3)
        mask_c = cmp_end[None, :] <= tpos[:, None]
        p_c = masked_softmax(jnp.einsum('bgrqd,bgnd->bgrqn', qb, kc) * scale, mask_c)
        o_c = jnp.einsum('bgrqn,bgnd->bgrqd', p_c.astype(vc.dtype), vc)
        imp = jnp.einsum('bgrqn,nj->bgqj', p_c, overlap).astype(jnp.float32)
        cur = tpos // SLC_BLOCK
        valid = blk[None, :] <= cur[:, None]
        forced = (blk[None, :] == 0) | (blk[None, :] == cur[:, None]) | (blk[None, :] == cur[:, None] - 1)
        imp = jnp.where(forced, FORCED_SCORE, jnp.where(valid, imp, -1.0))
        _, sel = lax.top_k(imp, top)
        tok = (sel[..., None] * SLC_BLOCK + jnp.arange(SLC_BLOCK)).reshape(
            bsz, grp, Q_BLOCK, top * SLC_BLOCK)
        mask_s = (tok <= tpos[:, None])[:, :, None]
        ks = gather(k_slc, tok)
        vs = gather(v_slc, tok)
        p_s = masked_softmax(jnp.einsum('bgrqd,bgqtd->bgrqt', qb, ks) * scale, mask_s)
        o_s = jnp.einsum('bgrqt,bgqtd->bgrqd', p_s.astype(vs.dtype), vs)
        kw = lax.dynamic_slice_in_dim(kwp, t0, WINDOW + Q_BLOCK, axis=2)
        vw = lax.dynamic_slice_in_dim(vwp, t0, WINDOW + Q_BLOCK, axis=2)
        kpos = t0 - WINDOW + jnp.arange(WINDOW + Q_BLOCK)
        dlt = tpos[:, None] - kpos[None, :]
        mask_w = (kpos[None, :] >= 0) & (dlt >= 0) & (dlt < WINDOW)
        p_w = masked_softmax(jnp.einsum('bgrqd,bgkd->bgrqk', qb, kw) * scale, mask_w)
        o_w = jnp.einsum('bgrqk,bgkd->bgrqd', p_w.astype(vw.dtype), vw)
        return gb[..., 0:1] * o_c + gb[..., 1:2] * o_s + gb[..., 2:3] * o_w

    out = lax.map(block_fn, jnp.arange(seq // Q_BLOCK))
    return out.transpose(1, 0, 4, 2, 3, 5).reshape(bsz, seq, NSA_HEADS * dh)


def ssd_chunked(x, dt, a_head, b_in, c_in):
    in_dtype = x.dtype
    f32 = jnp.float32
    bsz, seq, nh, hp = x.shape
    ng, ns = b_in.shape[2], b_in.shape[3]
    cl = math.gcd(SSD_CHUNK, seq)
    nc = seq // cl
    xdt = (x.astype(f32) * dt.astype(f32)[..., None]).reshape(bsz, nc, cl, nh, hp)
    a = (dt.astype(f32) * a_head.astype(f32)).reshape(bsz, nc, cl, nh).transpose(0, 3, 1, 2)
    bh = jnp.repeat(b_in.astype(f32), nh // ng, axis=2).reshape(bsz, nc, cl, nh, ns)
    ch = jnp.repeat(c_in.astype(f32), nh // ng, axis=2).reshape(bsz, nc, cl, nh, ns)
    a_cs = jnp.cumsum(a, axis=-1)
    causal = np.tril(np.ones((cl, cl), dtype=bool))
    decay_in = jnp.exp(jnp.where(causal, a_cs[..., :, None] - a_cs[..., None, :], -jnp.inf))
    cb = jnp.einsum('bclhn,bcshn->bhcls', ch, bh) * decay_in
    y_diag = jnp.einsum('bhcls,bcshp->bclhp', cb, xdt)
    states = jnp.einsum('bclhn,bhcl,bclhp->bchpn', bh, jnp.exp(a_cs[..., -1:] - a_cs), xdt)
    chunk_decay = jnp.exp(a_cs[..., -1])

    def step(hs, inp):
        st, dec = inp
        return hs * dec[..., None, None] + st, hs

    _, prev = lax.scan(step, jnp.zeros((bsz, nh, hp, ns), f32),
                       (states.transpose(1, 0, 2, 3, 4), chunk_decay.transpose(2, 0, 1)))
    prev = prev.transpose(1, 0, 2, 3, 4)
    y_off = jnp.einsum('bclhn,bchpn,bhcl->bclhp', ch, prev, jnp.exp(a_cs))
    return (y_diag + y_off).reshape(bsz, seq, nh, hp).astype(in_dtype)


def gated_delta_chunked(q, k, v, g, beta):
    in_dtype = v.dtype
    f32 = jnp.float32
    bsz, seq, nh, dk = q.shape
    dv = v.shape[-1]
    cl = GDN_CHUNK
    nc = seq // cl

    def chunks(t):
        return t.astype(f32).reshape(bsz, nc, cl, nh, -1).transpose(0, 3, 1, 2, 4)

    q = chunks(q) * dk ** -0.5
    k = chunks(k)
    v = chunks(v)
    beta = chunks(beta[..., None])[..., 0]
    g_cs = jnp.cumsum(chunks(g[..., None])[..., 0], axis=-1)
    incl = np.tril(np.ones((cl, cl), dtype=bool))
    strict = np.tril(np.ones((cl, cl), dtype=bool), -1)
    decay = jnp.exp(jnp.where(incl, g_cs[..., :, None] - g_cs[..., None, :], -jnp.inf))
    kb = k * beta[..., None]
    a_kk = jnp.where(strict, jnp.einsum('bhncd,bhnsd->bhncs', kb, k) * decay, 0.0)
    eye = jnp.eye(cl, dtype=f32)
    t_inv = lax.linalg.triangular_solve(a_kk + eye, jnp.broadcast_to(eye, a_kk.shape),
                                        left_side=True, lower=True, unit_diagonal=True)
    u = jnp.einsum('bhncs,bhnsd->bhncd', t_inv, v * beta[..., None])
    w = jnp.einsum('bhncs,bhnsd->bhncd', t_inv, kb * jnp.exp(g_cs)[..., None])
    a_qk = jnp.einsum('bhncd,bhnsd->bhncs', q, k) * decay

    def step(state, inp):
        q_i, k_i, u_i, w_i, a_i, g_i = inp
        v_new = u_i - jnp.einsum('bhcd,bhde->bhce', w_i, state)
        o = (jnp.einsum('bhcd,bhde->bhce', q_i * jnp.exp(g_i)[..., None], state)
             + jnp.einsum('bhcs,bhse->bhce', a_i, v_new))
        g_last = g_i[..., -1:]
        state = (state * jnp.exp(g_last)[..., None]
                 + jnp.einsum('bhcd,bhce->bhde', k_i * jnp.exp(g_last - g_i)[..., None], v_new))
        return state, o

    xs = tuple(jnp.moveaxis(t, 2, 0) for t in (q, k, u, w, a_qk, g_cs))
    _, o = lax.scan(step, jnp.zeros((bsz, nh, dk, dv), f32), xs)
    return o.transpose(1, 0, 3, 2, 4).reshape(bsz, seq, nh, dv).astype(in_dtype)


def hybrid_mixer(h, positions, w_in, w_out, pe_k, pe_v, ck_w1, ck_b1, ck_w2, cv_w1, cv_b1, cv_w2,
                 conv_w, conv_b, dt_bias, a_log, d_skip, norm_g):
    bsz, seq, _ = h.shape
    proj = h @ w_in
    q, kv, gate_logits, z, xbc, dt = split_last(proj, HY_SPLITS)
    q = partial_rope(q.reshape(bsz, seq, NSA_HEADS, NSA_HEAD_DIM), positions)
    kv = kv.reshape(bsz, seq, 6, NSA_KV_GROUPS, NSA_HEAD_DIM)
    k_cmp = partial_rope(kv[:, :, 0], positions)
    v_cmp = kv[:, :, 1]
    k_slc = partial_rope(kv[:, :, 2], positions)
    v_slc = kv[:, :, 3]
    k_win = partial_rope(kv[:, :, 4], positions)
    v_win = kv[:, :, 5]
    gates = jax.nn.sigmoid(gate_logits.reshape(bsz, seq, NSA_HEADS, 3))
    o_nsa = nsa_attention(q, k_cmp, v_cmp, k_slc, v_slc, k_win, v_win, gates,
                          pe_k, pe_v, ck_w1, ck_b1, ck_w2, cv_w1, cv_b1, cv_w2)
    xbc = jax.nn.silu(causal_dwconv(xbc, conv_w, conv_b))
    xs, bs, cs = split_last(xbc, (SSD_INNER, SSD_GROUPS * SSD_STATE, SSD_GROUPS * SSD_STATE))
    xs = xs.reshape(bsz, seq, SSD_HEADS, SSD_HEAD_DIM)
    dt = jax.nn.softplus(dt + dt_bias)
    y = ssd_chunked(xs, dt, -jnp.exp(a_log),
                    bs.reshape(bsz, seq, SSD_GROUPS, SSD_STATE),
                    cs.reshape(bsz, seq, SSD_GROUPS, SSD_STATE)) + d_skip[:, None] * xs
    y = y.reshape(bsz, seq, SSD_INNER) * jax.nn.silu(z)
    y = rms_norm(y.reshape(bsz, seq, SSD_GROUPS, SSD_INNER // SSD_GROUPS),
                 norm_g.reshape(SSD_GROUPS, SSD_INNER // SSD_GROUPS)).reshape(bsz, seq, SSD_INNER)
    return jnp.concatenate([o_nsa, y], axis=-1) @ w_out


def gdn_mixer(h, w_in, conv_w, dt_bias, a_log, norm_g, w_out):
    bsz, seq, _ = h.shape
    qkv, z, b, a = split_last(h @ w_in, GDN_SPLITS)
    qkv = jax.nn.silu(causal_dwconv(qkv, conv_w))
    q, k, v = split_last(qkv, (GDN_QK_W, GDN_QK_W, GDN_V_W))
    q = l2_norm(q.reshape(bsz, seq, GDN_HEADS, GDN_DK))
    k = l2_norm(k.reshape(bsz, seq, GDN_HEADS, GDN_DK))
    v = v.reshape(bsz, seq, GDN_HEADS, GDN_DV)
    beta = jax.nn.sigmoid(b)
    g = -jnp.exp(a_log) * jax.nn.softplus(a + dt_bias)
    o = gated_delta_chunked(q, k, v, g, beta)
    o = rms_norm(o, norm_g) * jax.nn.silu(z.reshape(bsz, seq, GDN_HEADS, GDN_DV))
    return o.reshape(bsz, seq, GDN_V_W) @ w_out


def conv_ffn(h, w_up, conv_w, conv_b, w_down):
    u = causal_dwconv(h @ w_up, conv_w, conv_b)
    gate, val = jnp.split(u, 2, axis=-1)
    return (jax.nn.silu(gate) * val) @ w_down


def setup_inputs(seed: int = 0) -> dict:
    key = jax.random.key(seed)
    keys = iter(jax.random.split(key, 40))
    f32 = jnp.float32

    def nrm(shape, scale):
        return jax.random.normal(next(keys), shape, f32) * scale

    def gain(shape):
        return 1.0 + nrm(shape, 0.02)

    def dt_bias(shape):
        u = jax.random.uniform(next(keys), shape, f32)
        dt = jnp.exp(u * (math.log(0.1) - math.log(1e-3)) + math.log(1e-3))
        return dt + jnp.log(-jnp.expm1(-dt))

    def a_log(shape):
        return jnp.log(jax.random.uniform(next(keys), shape, f32, 1.0, 16.0))

    E, O, L = N_EVEN, N_ODD, DEPTH
    dh = NSA_HEAD_DIM
    x = jax.random.normal(next(keys), (BATCH, SEQ, D_MODEL), f32)
    offs = jax.random.randint(next(keys), (BATCH, 1), 0, 1024, dtype=jnp.int32)
    positions = (offs + jnp.arange(SEQ, dtype=jnp.int32)[None, :]).astype(jnp.int32)
    return {
        'x': x,
        'positions': positions,
        'norm_mix_pre': gain((L, D_MODEL)),
        'norm_mix_post': gain((L, D_MODEL)),
        'norm_ffn_pre': gain((L, D_MODEL)),
        'norm_ffn_post': gain((L, D_MODEL)),
        'hy_w_in': nrm((E, D_MODEL, HY_IN_W), D_MODEL ** -0.5),
        'hy_w_out': nrm((E, HY_MIX_W, D_MODEL), HY_MIX_W ** -0.5),
        'nsa_pe_k': nrm((E, CMP_BLOCK, dh), 0.02),
        'nsa_pe_v': nrm((E, CMP_BLOCK, dh), 0.02),
        'nsa_ck_w1': nrm((E, CMP_BLOCK * dh, dh), (CMP_BLOCK * dh) ** -0.5),
        'nsa_ck_b1': nrm((E, dh), 0.01),
        'nsa_ck_w2': nrm((E, dh, dh), dh ** -0.5),
        'nsa_cv_w1': nrm((E, CMP_BLOCK * dh, dh), (CMP_BLOCK * dh) ** -0.5),
        'nsa_cv_b1': nrm((E, dh), 0.01),
        'nsa_cv_w2': nrm((E, dh, dh), dh ** -0.5),
        'ssd_conv_w': nrm((E, SSD_CONV, SSD_CONV_DIM), SSD_CONV ** -0.5),
        'ssd_conv_b': nrm((E, SSD_CONV_DIM), 0.01),
        'ssd_dt_bias': dt_bias((E, SSD_HEADS)),
        'ssd_a_log': a_log((E, SSD_HEADS)),
        'ssd_d': gain((E, SSD_HEADS)),
        'ssd_norm': gain((E, SSD_INNER)),
        'gdn_w_in': nrm((O, D_MODEL, GDN_IN_W), D_MODEL ** -0.5),
        'gdn_conv_w': nrm((O, GDN_CONV, GDN_CONV_DIM), GDN_CONV ** -0.5),
        'gdn_dt_bias': dt_bias((O, GDN_HEADS)),
        'gdn_a_log': a_log((O, GDN_HEADS)),
        'gdn_norm': gain((O, GDN_DV)),
        'gdn_w_out': nrm((O, GDN_V_W, D_MODEL), GDN_V_W ** -0.5),
        'ffn_w_up': nrm((L, D_MODEL, 2 * FFN_DIM), D_MODEL ** -0.5),
        'ffn_conv_w': nrm((L, FFN_CONV, 2 * FFN_DIM), FFN_CONV ** -0.5),
        'ffn_conv_b': nrm((L, 2 * FFN_DIM), 0.01),
        'ffn_w_down': nrm((L, FFN_DIM, D_MODEL), FFN_DIM ** -0.5),
    }


def reference(x, positions, norm_mix_pre, norm_mix_post, norm_ffn_pre, norm_ffn_post,
              hy_w_in, hy_w_out, nsa_pe_k, nsa_pe_v, nsa_ck_w1, nsa_ck_b1, nsa_ck_w2,
              nsa_cv_w1, nsa_cv_b1, nsa_cv_w2, ssd_conv_w, ssd_conv_b, ssd_dt_bias, ssd_a_log,
              ssd_d, ssd_norm, gdn_w_in, gdn_conv_w, gdn_dt_bias, gdn_a_log, gdn_norm, gdn_w_out,
              ffn_w_up, ffn_conv_w, ffn_conv_b, ffn_w_down):
    for layer in range(DEPTH):
        e = layer // 2
        hn = rms_norm(x, norm_mix_pre[layer])
        if layer % 2 == 0:
            mix = hybrid_mixer(hn, positions, hy_w_in[e], hy_w_out[e], nsa_pe_k[e], nsa_pe_v[e],
                               nsa_ck_w1[e], nsa_ck_b1[e], nsa_ck_w2[e], nsa_cv_w1[e], nsa_cv_b1[e],
                               nsa_cv_w2[e], ssd_conv_w[e], ssd_conv_b[e], ssd_dt_bias[e],
                               ssd_a_log[e], ssd_d[e], ssd_norm[e])
        else:
            mix = gdn_mixer(hn, gdn_w_in[e], gdn_conv_w[e], gdn_dt_bias[e], gdn_a_log[e],
                            gdn_norm[e], gdn_w_out[e])
        x = x + rms_norm(mix, norm_mix_post[layer])
        hn = rms_norm(x, norm_ffn_pre[layer])
        f = conv_ffn(hn, ffn_w_up[layer], ffn_conv_w[layer], ffn_conv_b[layer], ffn_w_down[layer])
        x = x + rms_norm(f, norm_ffn_post[layer])
    return x
```

```cpp
#include <hip/hip_runtime.h>
#include <hip/hip_cooperative_groups.h>
#include <cstdio>
#include <cstdint>
#ifndef MK_ONE_LAUNCH
#define MK_ONE_LAUNCH 1
#endif
namespace pg8 {
#define PG8_LAS __attribute__((address_space(3)))
typedef unsigned short bf16_t;
typedef short bf16x8 __attribute__((ext_vector_type(8)));
typedef float f32x4 __attribute__((ext_vector_type(4)));
typedef unsigned u32x4 __attribute__((ext_vector_type(4)));
constexpr int BM = 256, BK = 64, HALF = 128, HTB = HALF * BK * 2  , STAGE_BYTES = 8 * HTB, NXCD = 8, WGM = 8;

__host__ __device__ __forceinline__ int lds_byte(int r, int c) { const int st = (r >> 4) * 2 + (c >> 5), rr = r & 15, cc = c & 31, ob = rr * 64 + cc * 2; return st * 1024 + (ob ^ (((ob >> 9) & 1) << 5)); }
__host__ __device__ __forceinline__ void stage_rc(int b, int& R, int& C) { const int st = b / 1024, sb = b % 1024, swz = sb ^ (((sb >> 9) & 1) << 5); R = (st >> 1) * 16 + swz / 64; C = (st & 1) * 32 + (swz % 64) / 2; }
__host__ __device__ __forceinline__ int perm32(int rho) { const int n = rho >> 4, i = rho & 15; return 8 * (i >> 2) + 4 * n + (i & 3); }

struct Unit { int pm, pn; };
struct Gemm { const bf16_t* A; const bf16_t* Bt; int M, N, K; };

struct StaticOrder {
    int nM, nN, nwg, G, c;
    __host__ __device__ void init(int M, int N, int G_, int c_) { nM = M / BM; nN = N / BM; nwg = nM * nN; G = G_; c = c_; }
    __host__ __device__ bool next(int i, Unit& u) const {
        const long L = (long)i * G + c; if (L >= nwg) return false;
        int wgid = (int)L; { const int q = nwg / NXCD, r = nwg % NXCD, xcd = wgid % NXCD, off = wgid / NXCD; wgid = (xcd < r ? xcd * (q + 1) : r * (q + 1) + (xcd - r) * q) + off; }
        const int nig = WGM * nN, gid = wgid / nig, fm = gid * WGM, gsz = (nM - fm) < WGM ? (nM - fm) : WGM;
        u.pm = fm + ((wgid % nig) % gsz); u.pn = (wgid % nig) / gsz; return true;
    }
    __device__ __forceinline__ void a_ready(const Unit&) const {}
    __device__ __forceinline__ void done(const Unit&) const {}
};

__device__ __forceinline__ unsigned cvt_pk_bf16(float lo, float hi) { unsigned r; asm volatile("v_cvt_pk_bf16_f32 %0, %1, %2" : "=v"(r) : "v"(lo), "v"(hi)); return r; }

template <class Epi, class Sched, bool ALIGN_EPI = false, bool SP2 = false>
__device__ __forceinline__ void gemm_phase(PG8_LAS unsigned char* lds, const Gemm g, const Sched& S, const Epi& E, const int tid) {
    const int  wid = __builtin_amdgcn_readfirstlane(tid >> 6), lane = tid & 63, wr = wid >> 2, wc = wid & 3, fr = lane & 15, fq = lane >> 4;
    const int K = g.K, nt = K / BK;
    unsigned voffA[2], voffB[2];
#pragma unroll
    for (int i = 0; i < 2; ++i) { int R, C; stage_rc(tid * 16 + i * 8192, R, C); const int Rb = Epi::PERM ? ((R & ~31) + perm32(R & 31)) : R;
        voffA[i] = (unsigned)(R * K + C) * 2u; voffB[i] = (unsigned)(Rb * K + C) * 2u; }
    const size_t kstep = (size_t)(BK * 2);
    const size_t hstep = (size_t)HALF * K * 2;
    const size_t tstep = 2 * hstep;
    const unsigned ldsw = (unsigned)wid * 1024u;
    const int aoff = lds_byte(wr * 64 + fr, fq * 8), boff = lds_byte(wc * 32 + fr, fq * 8);
#define PG8_SA(b, h) (((b) * 2 + (h)) * HTB)
#define PG8_SB(b, h) ((4 + (b) * 2 + (h)) * HTB)
#define PG8_STAGE(bufoff, gbase, voff) do { _Pragma("unroll") for (int _i = 0; _i < 2; ++_i) \
        __builtin_amdgcn_global_load_lds((const unsigned*)((const char*)(gbase) + (voff)[_i]), (PG8_LAS unsigned*)(lds + (bufoff) + ldsw + _i * 8192), 16, 0, 0); } while (0)
#define PG8_LDA(dst, b, h) do { _Pragma("unroll") for (int m = 0; m < 4; ++m) _Pragma("unroll") for (int k = 0; k < 2; ++k) dst[m][k] = *(const PG8_LAS bf16x8*)(lds + PG8_SA(b, h) + aoff + m * 2048 + k * 1024); } while (0)
#define PG8_LDB(dst, b, h) do { _Pragma("unroll") for (int n = 0; n < 2; ++n) _Pragma("unroll") for (int k = 0; k < 2; ++k) dst[n][k] = *(const PG8_LAS bf16x8*)(lds + PG8_SB(b, h) + boff + n * 2048 + k * 1024); } while (0)
#define PG8_MMA(ai, bj, At, Bt) do { __builtin_amdgcn_s_setprio(1); _Pragma("unroll") for (int m = 0; m < 4; ++m) _Pragma("unroll") for (int n = 0; n < 2; ++n) _Pragma("unroll") for (int k = 0; k < 2; ++k) \
        acc[ai][bj][m][n] = __builtin_amdgcn_mfma_f32_16x16x32_bf16(Bt[n][k], At[m][k], acc[ai][bj][m][n], 0, 0, 0); __builtin_amdgcn_s_setprio(0); } while (0)
#define PG8_WAIT_V(n) asm volatile("s_waitcnt vmcnt(" #n ")" ::: "memory")
#define PG8_WAIT_L(n) asm volatile("s_waitcnt lgkmcnt(" #n ")" ::: "memory")
#define PG8_BAR __builtin_amdgcn_s_barrier()
#define PG8_SCHED __builtin_amdgcn_sched_barrier(0)
    Unit cur, nxt; int ui = 0;
    if (!S.next(0, cur)) return;
    f32x4 acc[2][2][4][2];
#pragma unroll
    for (int a = 0; a < 2; ++a)
#pragma unroll
        for (int b = 0; b < 2; ++b)
#pragma unroll
            for (int m = 0; m < 4; ++m)
#pragma unroll
                for (int n = 0; n < 2; ++n) acc[a][b][m][n] = (f32x4){0.f, 0.f, 0.f, 0.f};
    bf16x8 At[4][2], B0[2][2], B1[2][2];
    const char* cA = (const char*)g.A + (size_t)cur.pm * tstep; const char* cB = (const char*)g.Bt + (size_t)cur.pn * tstep;
    S.a_ready(cur);
    if constexpr (SP2) {
        PG8_STAGE(PG8_SB(0, 0), cB, voffB); PG8_STAGE(PG8_SB(0, 1), cB + hstep, voffB); PG8_STAGE(PG8_SA(0, 0), cA, voffA); PG8_STAGE(PG8_SA(0, 1), cA + hstep, voffA);
        if (wr == 1) PG8_BAR;
        PG8_WAIT_V(2); PG8_BAR;
        PG8_STAGE(PG8_SB(1, 0), cB + kstep, voffB); PG8_STAGE(PG8_SA(1, 0), cA + kstep, voffA); PG8_STAGE(PG8_SB(1, 1), cB + hstep + kstep, voffB);
        PG8_WAIT_V(6); PG8_BAR;
    } else {
        PG8_STAGE(PG8_SB(0, 0), cB, voffB); PG8_STAGE(PG8_SA(0, 0), cA, voffA); PG8_STAGE(PG8_SB(0, 1), cB + hstep, voffB); PG8_STAGE(PG8_SA(0, 1), cA + hstep, voffA);
        if (wr == 1) PG8_BAR;
        PG8_WAIT_V(4); PG8_BAR;
        PG8_STAGE(PG8_SB(1, 0), cB + kstep, voffB); PG8_STAGE(PG8_SA(1, 0), cA + kstep, voffA); PG8_STAGE(PG8_SB(1, 1), cB + hstep + kstep, voffB);
        PG8_WAIT_V(6); PG8_BAR;
    }
    for (;;) {
        const bool has_next = S.next(ui + 1, nxt);
        const char* nA = has_next ? (const char*)g.A + (size_t)nxt.pm * tstep : cA; const char* nB = has_next ? (const char*)g.Bt + (size_t)nxt.pn * tstep : cB;
        for (int t = 0; t < nt; t += 2) {
            const bool last = (t == nt - 2);
            const char* a1 = cA + (size_t)(t + 1) * kstep;
            const char* a2 = last ? nA : cA + (size_t)(t + 2) * kstep; const char* b2 = last ? nB : cB + (size_t)(t + 2) * kstep;
            const char* a3 = a2 + kstep; const char* b3 = b2 + kstep;
            if (last && has_next) S.a_ready(nxt);
            if constexpr (SP2) {
            PG8_LDB(B0, 0, 0); PG8_LDB(B1, 0, 1); PG8_SCHED; PG8_LDA(At, 0, 0); PG8_STAGE(PG8_SA(1, 1), a1 + hstep, voffA);
            PG8_WAIT_V(8); PG8_WAIT_L(0); PG8_BAR; PG8_MMA(0, 0, At, B0); PG8_MMA(0, 1, At, B1); PG8_BAR; PG8_SCHED;
            PG8_LDA(At, 0, 1); PG8_STAGE(PG8_SB(0, 0), b2, voffB); PG8_STAGE(PG8_SB(0, 1), b2 + hstep, voffB); PG8_STAGE(PG8_SA(0, 0), a2, voffA);
            PG8_WAIT_V(8); PG8_WAIT_L(0); PG8_BAR; PG8_MMA(1, 0, At, B0); PG8_MMA(1, 1, At, B1); PG8_BAR; PG8_SCHED;
            PG8_LDB(B0, 1, 0); PG8_LDB(B1, 1, 1); PG8_SCHED; PG8_LDA(At, 1, 0); PG8_STAGE(PG8_SA(0, 1), a2 + hstep, voffA);
            PG8_WAIT_V(8); PG8_WAIT_L(0); PG8_BAR; PG8_MMA(0, 0, At, B0); PG8_MMA(0, 1, At, B1); PG8_BAR; PG8_SCHED;
            PG8_LDA(At, 1, 1); PG8_STAGE(PG8_SB(1, 0), b3, voffB); PG8_STAGE(PG8_SB(1, 1), b3 + hstep, voffB); PG8_STAGE(PG8_SA(1, 0), a3, voffA);
            PG8_WAIT_V(8); PG8_WAIT_L(0); PG8_BAR; PG8_MMA(1, 0, At, B0); PG8_MMA(1, 1, At, B1); PG8_BAR; PG8_SCHED;
            } else {
            PG8_LDB(B0, 0, 0); PG8_SCHED; PG8_LDA(At, 0, 0); PG8_STAGE(PG8_SA(1, 1), a1 + hstep, voffA);
            PG8_WAIT_L(8); PG8_BAR; PG8_WAIT_L(0); PG8_MMA(0, 0, At, B0); PG8_BAR; PG8_SCHED;
            PG8_LDB(B1, 0, 1); PG8_STAGE(PG8_SB(0, 0), b2, voffB);
            PG8_BAR; PG8_WAIT_L(0); PG8_MMA(0, 1, At, B1); PG8_BAR;
            PG8_LDA(At, 0, 1); PG8_STAGE(PG8_SA(0, 0), a2, voffA);
            PG8_BAR; PG8_WAIT_L(0); PG8_MMA(1, 0, At, B0); PG8_BAR; PG8_SCHED;
            PG8_STAGE(PG8_SB(0, 1), b2 + hstep, voffB);
            PG8_WAIT_V(6); PG8_BAR; PG8_MMA(1, 1, At, B1); PG8_BAR;
            PG8_LDB(B0, 1, 0); PG8_SCHED; PG8_LDA(At, 1, 0); PG8_STAGE(PG8_SA(0, 1), a2 + hstep, voffA);
            PG8_WAIT_L(8); PG8_BAR; PG8_WAIT_L(0); PG8_MMA(0, 0, At, B0); PG8_BAR; PG8_SCHED;
            PG8_LDB(B1, 1, 1); PG8_STAGE(PG8_SB(1, 0), b3, voffB);
            PG8_BAR; PG8_WAIT_L(0); PG8_MMA(0, 1, At, B1); PG8_BAR;
            PG8_LDA(At, 1, 1); PG8_STAGE(PG8_SA(1, 0), a3, voffA);
            PG8_BAR; PG8_WAIT_L(0); PG8_MMA(1, 0, At, B0); PG8_BAR; PG8_SCHED;
            PG8_STAGE(PG8_SB(1, 1), b3 + hstep, voffB);
            PG8_WAIT_V(6); PG8_BAR; PG8_MMA(1, 1, At, B1); PG8_BAR;
            }
        }
        if constexpr (ALIGN_EPI) { if (wr == 0) PG8_BAR; }
        if constexpr (!Epi::AFTER_DRAIN) { E(acc, cur, wr, wc, fr, fq); S.done(cur); }
        if (!has_next) break;
#pragma unroll
        for (int a = 0; a < 2; ++a)
#pragma unroll
            for (int b = 0; b < 2; ++b)
#pragma unroll
                for (int m = 0; m < 4; ++m)
#pragma unroll
                    for (int n = 0; n < 2; ++n) acc[a][b][m][n] = (f32x4){0.f, 0.f, 0.f, 0.f};
        cur = nxt; cA = nA; cB = nB; ++ui;
        if constexpr (ALIGN_EPI) { if (wr == 1) PG8_BAR; }
    }
    PG8_WAIT_V(0);
    if constexpr (!ALIGN_EPI) { if (wr == 0) PG8_BAR; }
    PG8_BAR;
    if constexpr (Epi::AFTER_DRAIN) { E.fused(acc, cur, wr, wc, fr, fq, lds, wid, lane); S.done(cur); }
#undef PG8_SA
#undef PG8_SB
#undef PG8_STAGE
#undef PG8_LDA
#undef PG8_LDB
#undef PG8_MMA
#undef PG8_WAIT_V
#undef PG8_WAIT_L
#undef PG8_BAR
#undef PG8_SCHED
}
}
constexpr int NB = 4, SEQ = 8192, DM = 1024, NTOK = NB * SEQ;
constexpr int HY_N = 2848, HY_NP = 3072;
constexpr int C_KV = 512, C_GATE = 1280, C_Z = 1304, C_XBC = 1816, C_DT = 2840;
constexpr int GDN_N = 4112, GDN_NP = 4352;
constexpr int FF = 2816, FF2 = 5632;
constexpr int NCMP = 511, NCMP_P = 512;
constexpr float NORM_EPS = 1e-6f;

constexpr size_t MiB = 1u << 20;
constexpr size_t WS_CTL = 0, CTL_ZERO_BYTES = 1 * MiB;
constexpr size_t WS_W_HYIN = 1 * MiB, WS_W_HYOUT = 7 * MiB, WS_W_GDNIN = 9 * MiB, WS_W_GDNOUT = 18 * MiB;
constexpr size_t WS_W_UP0 = 20 * MiB, WS_W_UP1 = 31 * MiB, WS_W_DN0 = 42 * MiB, WS_W_DN1 = 48 * MiB;
constexpr size_t WS_ROPE = 54 * MiB;
constexpr size_t WS_HN = 56 * MiB;
constexpr size_t WS_PROJ = 120 * MiB;
constexpr size_t WS_SIDE = 312 * MiB;
constexpr size_t WS_XBC = 316 * MiB;
constexpr size_t WS_MIXIN = 380 * MiB;
constexpr size_t WS_DT = 444 * MiB;
constexpr size_t WS_ACS = 445 * MiB;
constexpr size_t WS_ST = 446 * MiB;
constexpr size_t WS_KC = 478 * MiB, WS_VC = 479 * MiB;
constexpr size_t WS_MIX = 120 * MiB;
constexpr size_t WS_U = 120 * MiB;
constexpr size_t WS_ACT = 208 * MiB;
constexpr size_t WS_F = 252 * MiB;
constexpr size_t WS_QKV = 120 * MiB;
constexpr size_t WS_Z1 = 312 * MiB;
constexpr size_t WS_SIDE2 = 376 * MiB;
constexpr size_t WS_QN = 56 * MiB;
constexpr size_t WS_KN = 378 * MiB, WS_VN = 442 * MiB;
constexpr size_t WS_BETA = 506 * MiB, WS_G = 507 * MiB;
constexpr size_t WS_O1 = 120 * MiB;
constexpr size_t WS_GIN = 248 * MiB;
constexpr size_t WS_MIX1 = 312 * MiB;
constexpr size_t WS_END = 508 * MiB;
constexpr int CW_BAR = 4096;

constexpr int LDS_BYTES = 147456;
constexpr int MISC_OFF = 146944;
constexpr int PTR_OFF = MISC_OFF + 64;

#define GAS __attribute__((address_space(1)))
#define LAS __attribute__((address_space(3)))
typedef unsigned short bf16;
typedef unsigned v4u __attribute__((ext_vector_type(4)));
typedef unsigned v2u __attribute__((ext_vector_type(2)));
typedef float f32x4 __attribute__((ext_vector_type(4)));
typedef GAS unsigned gu32;
#define RLX_AGENT __ATOMIC_RELAXED, __HIP_MEMORY_SCOPE_AGENT
#define LDS_WAIT() asm volatile("s_waitcnt lgkmcnt(0)" ::: "memory")
#define VM_WAIT() asm volatile("s_waitcnt vmcnt(0)" ::: "memory")
__device__ __forceinline__ unsigned f2bf(float f) { unsigned u = __builtin_bit_cast(unsigned, f); return (u + 0x7fffu + ((u >> 16) & 1u)) >> 16; }
__device__ __forceinline__ unsigned pk2(float lo, float hi) { return f2bf(lo) | (f2bf(hi) << 16); }
__device__ __forceinline__ float bf2f(unsigned short v) { return __builtin_bit_cast(float, ((unsigned)v) << 16); }
__device__ __forceinline__ float bflo(unsigned u) { return __builtin_bit_cast(float, u << 16); }
__device__ __forceinline__ float bfhi(unsigned u) { return __builtin_bit_cast(float, u & 0xffff0000u); }
__device__ __forceinline__ float wave_sum(float v) {
#pragma unroll
    for (int o = 1; o < 64; o <<= 1) v += __shfl_xor(v, o);
    return v;
}
__device__ __forceinline__ float wave_max(float v) {
#pragma unroll
    for (int o = 1; o < 64; o <<= 1) v = fmaxf(v, __shfl_xor(v, o));
    return v;
}
__device__ __forceinline__ float siluf(float x) { return x / (1.f + __expf(-x)); }
__device__ __forceinline__ float sigmf(float x) { return 1.f / (1.f + __expf(-x)); }
__device__ __forceinline__ float softplusf(float x) { return fmaxf(x, 0.f) + log1pf(__expf(-fabsf(x))); }
#define XB_TMO      128
#define XB_XCNT(j)  (256  + 64 * (j))
#define XB_XSUB(j)  (1280 + 64 * (j))
#define XB_XGEN(j)  (2304 + 64 * (j))
#define XB_TOP      3328
#define XB_TOPGEN   3392
#define XCD_BAR_WORDS 3456
#define XB_SPIN_CAP (1u << 18)

__device__ __forceinline__ unsigned xb_ld(unsigned* p)              { return __hip_atomic_load(p, __ATOMIC_RELAXED, __HIP_MEMORY_SCOPE_AGENT); }
__device__ __forceinline__ unsigned xb_add(unsigned* p, unsigned v) { return __hip_atomic_fetch_add(p, v, __ATOMIC_RELAXED, __HIP_MEMORY_SCOPE_AGENT); }
__device__ __forceinline__ unsigned xb_xcc_id() { return (unsigned)__builtin_amdgcn_s_getreg((3 << 11) | 20) & 0xFu; }
#define XB_SPIN(cond, bar) do { unsigned _sp = 0; while (cond) { __builtin_amdgcn_s_sleep(1); \
    if ((++_sp & 255u) == 0u) { if (xb_ld(&(bar)[XB_TMO])) break; if (_sp > XB_SPIN_CAP) { atomicAdd(&(bar)[XB_TMO], 1u); break; } } } } while (0)

struct XcdBarrier {
    unsigned* bar; unsigned x;
    volatile LAS unsigned* st;
};

__device__ __forceinline__ XcdBarrier xcd_barrier_post(unsigned* bar, volatile LAS unsigned* st) {
    XcdBarrier b; b.bar = bar; b.x = xb_xcc_id(); b.st = st;
    if (threadIdx.x == 0) (void)xb_add(&bar[XB_XCNT(b.x)], 1u);
    return b;
}
__device__ __forceinline__ void xcd_barrier_complete(unsigned* bar, unsigned x, unsigned& nloc, unsigned& nx) {
    const unsigned G = gridDim.x * gridDim.y * gridDim.z;
    unsigned sum, cnt, mine, sp = 0u;
    for (;;) {
        sum = 0u; cnt = 0u; mine = 0u;
#pragma unroll
        for (unsigned j = 0; j < 16; ++j) { const unsigned c = xb_ld(&bar[XB_XCNT(j)]); sum += c; cnt += (c > 0u) ? 1u : 0u; mine = (j == x) ? c : mine; }
        if (sum == G) break;
        __builtin_amdgcn_s_sleep(1);
        if ((++sp & 255u) == 0u) { if (xb_ld(&bar[XB_TMO])) break; if (sp > XB_SPIN_CAP) { atomicAdd(&bar[XB_TMO], 1u); break; } }
    }
    nloc = mine > 0u ? mine : 1u; nx = cnt > 0u ? cnt : 1u;
}

__device__ __forceinline__ void xcd_barrier(const XcdBarrier& b) {
    asm volatile("s_waitcnt vmcnt(0)" ::: "memory");
    __syncthreads();
    if (threadIdx.x == 0) {
        unsigned* bar = b.bar;
        __builtin_amdgcn_s_waitcnt(0);
        unsigned nloc = b.st[0], nx = b.st[1];
        if (nloc == 0u) { xcd_barrier_complete(bar, b.x, nloc, nx); b.st[0] = nloc; b.st[1] = nx; }
        const unsigned old = xb_add(&bar[XB_XSUB(b.x)], 1u);
        const unsigned gen = old / nloc;
        if (old + 1u == (gen + 1u) * nloc) {
            __builtin_amdgcn_fence(__ATOMIC_RELEASE, "agent");
            asm volatile("s_waitcnt vmcnt(0)" ::: "memory");
            const unsigned og = xb_add(&bar[XB_TOP], 1u);
            const unsigned tg = og / nx;
            if (og + 1u == (tg + 1u) * nx) xb_add(&bar[XB_TOPGEN], 1u);
            else XB_SPIN(xb_ld(&bar[XB_TOPGEN]) == tg, bar);
            __builtin_amdgcn_fence(__ATOMIC_ACQUIRE, "agent");
            xb_add(&bar[XB_XGEN(b.x)], 1u);
            asm volatile("s_waitcnt vmcnt(0)" ::: "memory");
        } else {
            XB_SPIN(xb_ld(&bar[XB_XGEN(b.x)]) == gen, bar);
            __builtin_amdgcn_fence(__ATOMIC_ACQUIRE, "agent");
            asm volatile("s_waitcnt vmcnt(0)" ::: "memory");
        }
    }
    __syncthreads();
}

#define EPI_LOOP(BODY) \
    _Pragma("unroll") for (int ai = 0; ai < 2; ++ai) _Pragma("unroll") for (int m = 0; m < 4; ++m) { const int row = u.pm * 256 + ai * 128 + wr * 64 + m * 16 + fr; \
    _Pragma("unroll") for (int bj = 0; bj < 2; ++bj) _Pragma("unroll") for (int n = 0; n < 2; ++n) { const int col = u.pn * 256 + bj * 128 + wc * 32 + n * 16 + 4 * fq; const f32x4 v = acc[ai][bj][m][n]; BODY } }

struct EpiF32 {
    static constexpr bool PERM = false, AFTER_DRAIN = false;
    float* O; int ldc;
    __device__ __forceinline__ void operator()(const pg8::f32x4 (&acc)[2][2][4][2], const pg8::Unit& u, int wr, int wc, int fr, int fq) const {
        EPI_LOOP( *(f32x4*)(O + (size_t)row * ldc + col) = v; )
    }
};
struct EpiB16 {
    static constexpr bool PERM = false, AFTER_DRAIN = false;
    bf16* O; int ldc;
    __device__ __forceinline__ void operator()(const pg8::f32x4 (&acc)[2][2][4][2], const pg8::Unit& u, int wr, int wc, int fr, int fq) const {
        EPI_LOOP( v2u w; w.x = pk2(v[0], v[1]); w.y = pk2(v[2], v[3]); *(v2u*)(O + (size_t)row * ldc + col) = w; )
    }
};
struct EpiHyIn {
    static constexpr bool PERM = false, AFTER_DRAIN = false;
    bf16* P; float* side;
    __device__ __forceinline__ void operator()(const pg8::f32x4 (&acc)[2][2][4][2], const pg8::Unit& u, int wr, int wc, int fr, int fq) const {
        EPI_LOOP( v2u w; w.x = pk2(v[0], v[1]); w.y = pk2(v[2], v[3]); *(v2u*)(P + (size_t)row * HY_NP + col) = w;
                  if (col >= C_GATE && col < C_Z) *(f32x4*)(side + (size_t)row * 32 + (col - C_GATE)) = v;
                  if (col >= C_DT && col < HY_N) *(f32x4*)(side + (size_t)row * 32 + 24 + (col - C_DT)) = v; )
    }
};
struct EpiGdnIn {
    static constexpr bool PERM = false, AFTER_DRAIN = false;
    bf16* QKV; bf16* Z; float* side;
    __device__ __forceinline__ void operator()(const pg8::f32x4 (&acc)[2][2][4][2], const pg8::Unit& u, int wr, int wc, int fr, int fq) const {
        EPI_LOOP( if (col < 3072) { v2u w; w.x = pk2(v[0], v[1]); w.y = pk2(v[2], v[3]); *(v2u*)(QKV + (size_t)row * 3072 + col) = w; }
                  else if (col < 4096) { v2u w; w.x = pk2(v[0], v[1]); w.y = pk2(v[2], v[3]); *(v2u*)(Z + (size_t)row * 1024 + (col - 3072)) = w; }
                  else if (col < GDN_N) *(f32x4*)(side + (size_t)row * 16 + (col - 4096)) = v; )
    }
};

struct InvFreq { float f[8]; };
struct Args { const float* in[32]; float* out; unsigned char* ws; int ph_lo, ph_hi; InvFreq ifq; };
struct Ctx {
    LAS unsigned char* lds;
    int tid, lane, wave, G, bid;
};
__device__ __forceinline__ unsigned char* ldptr(const Ctx& C, int k) {
    const LAS unsigned* t = (const LAS unsigned*)(C.lds + PTR_OFF) + 2 * k;
    const unsigned lo = __builtin_amdgcn_readfirstlane(t[0]), hi = __builtin_amdgcn_readfirstlane(t[1]);
    return (unsigned char*)(((unsigned long long)hi << 32) | (unsigned long long)lo);
}
#define WSP(T, off) ((T*)(ldptr(C, 33) + (off)))
#define INP(k) ((const float*)ldptr(C, (k)))
#define OUTP() ((float*)ldptr(C, 32))

__device__ __forceinline__ void wt_item(const float* W, int K, int N, bf16* WT, LAS float* scr, int item, int lane, int nblk) {
    const int kb = item / nblk, nb = item % nblk, k0 = 64 * kb, n0 = 32 * nb;
    const int nn = n0 + (lane & 31); const bool ok = nn < N;
#pragma unroll 8
    for (int i = 0; i < 32; ++i) { const int kk = 2 * i + (lane >> 5); scr[kk * 33 + (lane & 31)] = ok ? W[(size_t)(k0 + kk) * N + nn] : 0.f; }
    LDS_WAIT();
    const int c = lane & 7;
#pragma unroll
    for (int j = 0; j < 4; ++j) { const int n = (lane >> 3) + 8 * j; const LAS float* s = scr + (8 * c) * 33 + n;
        v4u o; o.x = pk2(s[0 * 33], s[1 * 33]); o.y = pk2(s[2 * 33], s[3 * 33]); o.z = pk2(s[4 * 33], s[5 * 33]); o.w = pk2(s[6 * 33], s[7 * 33]);
        *(v4u*)(WT + (size_t)(n0 + n) * K + k0 + 8 * c) = o; }
    LDS_WAIT();
}
__device__ __forceinline__ void wt_matrix(const Ctx& C, const float* W, int K, int N, int Np, bf16* WT) {
    LAS float* scr = (LAS float*)(C.lds + C.wave * 16384);
    const int gw = C.bid * 8 + C.wave, NGW = C.G * 8, nblk = Np / 32, items = (K / 64) * nblk;
    for (int it = gw; it < items; it += NGW) wt_item(W, K, N, WT, scr, it, C.lane, nblk);
}
__device__ __forceinline__ void rms_row_to_bf16(const float* xrow, const float* g, bf16* orow, int lane) {
    const f32x4* xr = (const f32x4*)xrow + lane; const f32x4* gr = (const f32x4*)g + lane;
    f32x4 v[4]; float s = 0.f;
#pragma unroll
    for (int j = 0; j < 4; ++j) { v[j] = xr[64 * j]; s += (v[j].x * v[j].x + v[j].y * v[j].y) + (v[j].z * v[j].z + v[j].w * v[j].w); }
    const float rs = 1.f / sqrtf(wave_sum(s) * (1.f / DM) + NORM_EPS);
    v2u* o8 = (v2u*)orow + lane;
#pragma unroll
    for (int j = 0; j < 4; ++j) { const f32x4 gg = gr[64 * j]; v2u w; w.x = pk2(v[j].x * rs * gg.x, v[j].y * rs * gg.y); w.y = pk2(v[j].z * rs * gg.z, v[j].w * rs * gg.w); o8[64 * j] = w; }
}
__device__ __forceinline__ void sincos_acc(float af, float& sn, float& cs) {
    const double a = (double)af;
    const double q = rint(a * 0.63661977236758134308);
    double r = fma(-q, 1.57079632679489655800e+00, a); r = fma(-q, 6.12323399573676603587e-17, r);
    const int n = ((int)q) & 3;
    const double r2 = r * r;
    double s = -1.0 / 6227020800.0; s = s * r2 + 1.0 / 39916800.0; s = s * r2 - 1.0 / 362880.0; s = s * r2 + 1.0 / 5040.0; s = s * r2 - 1.0 / 120.0; s = s * r2 + 1.0 / 6.0; s = r - r * r2 * s;
    double c = 1.0 / 87178291200.0; c = c * r2 - 1.0 / 479001600.0; c = c * r2 + 1.0 / 3628800.0; c = c * r2 - 1.0 / 40320.0; c = c * r2 + 1.0 / 720.0; c = c * r2 - 1.0 / 24.0; c = c * r2 + 0.5; c = 1.0 - r2 * c;
    double so, co;
    if (n == 0) { so = s; co = c; } else if (n == 1) { so = c; co = -s; } else if (n == 2) { so = -s; co = -c; } else { so = -c; co = s; }
    sn = (float)so; cs = (float)co;
}
__device__ __forceinline__ void phase_prologue(const Ctx& C) {
    const LAS float* ifq = (const LAS float*)(C.lds + PTR_OFF + 34 * 8);
    wt_matrix(C, INP(6), DM, HY_N, HY_NP, WSP(bf16, WS_W_HYIN));
    wt_matrix(C, INP(7), DM, DM, DM, WSP(bf16, WS_W_HYOUT));
    wt_matrix(C, INP(22), DM, GDN_N, GDN_NP, WSP(bf16, WS_W_GDNIN));
    wt_matrix(C, INP(27), DM, DM, DM, WSP(bf16, WS_W_GDNOUT));
    wt_matrix(C, INP(28), DM, FF2, FF2, WSP(bf16, WS_W_UP0));
    wt_matrix(C, INP(28) + (size_t)DM * FF2, DM, FF2, FF2, WSP(bf16, WS_W_UP1));
    wt_matrix(C, INP(31), FF, DM, DM, WSP(bf16, WS_W_DN0));
    wt_matrix(C, INP(31) + (size_t)FF * DM, FF, DM, DM, WSP(bf16, WS_W_DN1));
    { const int* pos = (const int*)INP(1); float* tab = WSP(float, WS_ROPE);
      for (int idx = C.bid * 512 + C.tid; idx < NTOK * 8; idx += C.G * 512) { const int tok = idx >> 3, i = idx & 7;
          float fr = ifq[0];
#pragma unroll
          for (int k = 1; k < 8; ++k) fr = (i == k) ? ifq[k] : fr;
          const float ang = (float)pos[tok] * fr; float sn, cs; sincos_acc(ang, sn, cs); tab[tok * 16 + i] = cs; tab[tok * 16 + 8 + i] = sn; } }
    { const int gw = C.bid * 8 + C.wave, NGW = C.G * 8; bf16* HN = WSP(bf16, WS_HN);
      for (int m = gw; m < NTOK; m += NGW) rms_row_to_bf16(INP(0) + (size_t)m * DM, INP(2), HN + (size_t)m * DM, C.lane); }
}

__device__ __forceinline__ void phase_res(const Ctx& C, const float* xin, float* xout, const float* mix, int row0, int nrows, const float* gpost, const float* gnext, bf16* HN) {
    const int gw = C.bid * 8 + C.wave, NGW = C.G * 8, lane = C.lane;
    for (int r = gw; r < nrows; r += NGW) {
        const size_t grow = (size_t)(row0 + r);
        const f32x4* mr = (const f32x4*)(mix + (size_t)r * DM) + lane; const f32x4* xr = (const f32x4*)(xin + grow * DM) + lane;
        f32x4 v[4]; float s = 0.f;
#pragma unroll
        for (int j = 0; j < 4; ++j) { v[j] = mr[64 * j]; s += (v[j].x * v[j].x + v[j].y * v[j].y) + (v[j].z * v[j].z + v[j].w * v[j].w); }
        const float rs = 1.f / sqrtf(wave_sum(s) * (1.f / DM) + NORM_EPS);
        float s2 = 0.f;
#pragma unroll
        for (int j = 0; j < 4; ++j) { const f32x4 gg = ((const f32x4*)gpost + lane)[64 * j]; const f32x4 xx = xr[64 * j];
            v[j].x = xx.x + v[j].x * rs * gg.x; v[j].y = xx.y + v[j].y * rs * gg.y; v[j].z = xx.z + v[j].z * rs * gg.z; v[j].w = xx.w + v[j].w * rs * gg.w;
            s2 += (v[j].x * v[j].x + v[j].y * v[j].y) + (v[j].z * v[j].z + v[j].w * v[j].w);
            ((f32x4*)(xout + grow * DM) + lane)[64 * j] = v[j]; }
        if (gnext) { const float rs2 = 1.f / sqrtf(wave_sum(s2) * (1.f / DM) + NORM_EPS); v2u* o8 = (v2u*)(HN + grow * DM) + lane;
#pragma unroll
            for (int j = 0; j < 4; ++j) { const f32x4 gg = ((const f32x4*)gnext + lane)[64 * j]; v2u w; w.x = pk2(v[j].x * rs2 * gg.x, v[j].y * rs2 * gg.y); w.y = pk2(v[j].z * rs2 * gg.z, v[j].w * rs2 * gg.w); o8[64 * j] = w; } }
    }
}

__device__ __forceinline__ void phase_rope_conv(const Ctx& C) {
    bf16* P = WSP(bf16, WS_PROJ); const float* tab = WSP(float, WS_ROPE);
    const int gt = C.bid * 512 + C.tid, NT = C.G * 512;
    for (int idx = gt; idx < NTOK * 112; idx += NT) {
        const int tok = idx / 112, rem = idx - tok * 112, hd = rem >> 3, i = rem & 7;
        const int col0 = hd < 8 ? hd * 64 : C_KV + ((hd - 8) >> 1) * 256 + ((hd - 8) & 1) * 64;
        bf16* p = P + (size_t)tok * HY_NP + col0 + i;
        const float x1 = bf2f(p[0]), x2 = bf2f(p[8]), cs = tab[tok * 16 + i], sn = tab[tok * 16 + 8 + i];
        p[0] = (bf16)f2bf(x1 * cs - x2 * sn); p[8] = (bf16)f2bf(x2 * cs + x1 * sn);
    }
    { const float* cw = INP(16); const float* cb = INP(17); bf16* X = WSP(bf16, WS_XBC);
      for (int idx = gt; idx < NTOK * 1024; idx += NT) { const int tok = idx >> 10, c = idx & 1023, s = tok & (SEQ - 1);
          float a = cb[c];
#pragma unroll
          for (int j = 0; j < 4; ++j) { const int ss = s - 3 + j; if (ss >= 0) a += cw[j * 1024 + c] * bf2f(P[(size_t)(tok - 3 + j) * HY_NP + C_XBC + c]); }
          X[idx] = (bf16)f2bf(siluf(a)); } }
    { const float* side = WSP(float, WS_SIDE); float* DT = WSP(float, WS_DT); const float* db = INP(18);
      for (int idx = gt; idx < NTOK * 8; idx += NT) { const int tok = idx >> 3, h = idx & 7; DT[idx] = softplusf(side[(size_t)tok * 32 + 24 + h] + db[h]); } }
}

__device__ __forceinline__ void phase_compress(const Ctx& C) {
    LAS float* X = (LAS float*)C.lds;
    LAS float* PE = X + 144 * 64;
    LAS float* HID = PE + 32 * 64;
    const bf16* P = WSP(bf16, WS_PROJ);
    for (int item = C.bid; item < 2 * NB * 2 * 64; item += C.G) {
        const int which = item & 1, g = (item >> 1) & 1, b = (item >> 2) & 3, nt = item >> 4;
        const float* pe = INP(8 + which); const float* w1 = INP(which ? 13 : 10); const float* b1 = INP(which ? 14 : 11); const float* w2 = INP(which ? 15 : 12);
        float* OUT = WSP(float, which ? WS_VC : WS_KC);
        const int col0 = C_KV + which * 128 + g * 64, t0 = nt * 128;
        for (int e = C.tid; e < 144 * 64; e += 512) { const int tt = e >> 6, d = e & 63, t = t0 + tt; X[e] = t < SEQ ? bf2f(P[(size_t)(b * SEQ + t) * HY_NP + col0 + d]) : 0.f; }
        for (int e = C.tid; e < 32 * 64; e += 512) PE[e] = pe[e];
        __syncthreads();
        const int nl = C.tid >> 6, c = C.tid & 63, n = nt * 8 + nl;
        float a = b1[c];
        for (int l = 0; l < 32; ++l) {
            const LAS float* xr = X + (16 * nl + l) * 64; const LAS float* pr = PE + l * 64; const float* wr = w1 + (size_t)(l * 64) * 64 + c;
#pragma unroll 8
            for (int d = 0; d < 64; ++d) a += (xr[d] + pr[d]) * wr[d * 64];
        }
        HID[nl * 64 + c] = siluf(a);
        __syncthreads();
        float o = 0.f;
#pragma unroll 8
        for (int j = 0; j < 64; ++j) o += HID[nl * 64 + j] * w2[j * 64 + c];
        if (n < NCMP) OUT[((size_t)(b * 2 + g) * NCMP_P + n) * 64 + c] = o;
        __syncthreads();
    }
}

__device__ __forceinline__ void phase_ssd_s1(const Ctx& C) {
    LAS float* XW = (LAS float*)C.lds;
    LAS float* AV = XW + 256 * 64;
    LAS float* CS = AV + 256;
    const bf16* X = WSP(bf16, WS_XBC); const float* DT = WSP(float, WS_DT); float* ACS = WSP(float, WS_ACS); float* ST = WSP(float, WS_ST);
    for (int item = C.bid; item < NB * 32 * 8; item += C.G) {
        const int h = item & 7, c = (item >> 3) & 31, b = item >> 8, g = h >> 2;
        const size_t tok0 = (size_t)b * SEQ + c * 256;
        const float Ah = -__expf(INP(19)[h]);
        if (C.tid < 256) AV[C.tid] = DT[(tok0 + C.tid) * 8 + h] * Ah;
        __syncthreads();
        if (C.tid < 256) { float s = 0.f; for (int i = 0; i <= C.tid; ++i) s += AV[i]; CS[C.tid] = s; ACS[(tok0 + C.tid) * 8 + h] = s; }
        __syncthreads();
        const float last = CS[255];
        for (int e = C.tid; e < 256 * 64; e += 512) { const int l = e >> 6, p = e & 63;
            XW[e] = bf2f(X[(tok0 + l) * 1024 + h * 64 + p]) * DT[(tok0 + l) * 8 + h] * __expf(last - CS[l]); }
        __syncthreads();
        const int n = C.tid & 127, pg = C.tid >> 7;
        float acc[16];
#pragma unroll
        for (int i = 0; i < 16; ++i) acc[i] = 0.f;
        for (int l = 0; l < 256; ++l) { const float bv = bf2f(X[(tok0 + l) * 1024 + 512 + g * 128 + n]); const LAS float* xw = XW + l * 64 + pg * 16;
#pragma unroll
            for (int i = 0; i < 16; ++i) acc[i] += bv * xw[i]; }
        float* st = ST + (((size_t)(b * 32 + c) * 8 + h) * 64) * 128;
#pragma unroll
        for (int i = 0; i < 16; ++i) st[(pg * 16 + i) * 128 + n] = acc[i];
        __syncthreads();
    }
}
__device__ __forceinline__ void phase_ssd_s2(const Ctx& C) {
    float* ST = WSP(float, WS_ST); const float* ACS = WSP(float, WS_ACS);
    for (int idx = C.bid * 512 + C.tid; idx < NB * 8 * 64 * 128; idx += C.G * 512) {
        const int pn = idx & 8191, h = (idx >> 13) & 7, b = idx >> 16;
        float hs = 0.f;
        for (int c = 0; c < 32; ++c) { float* p = ST + (((size_t)(b * 32 + c) * 8 + h) * 8192) + pn; const float t = *p; *p = hs;
            hs = hs * __expf(ACS[((size_t)b * SEQ + c * 256 + 255) * 8 + h]) + t; }
    }
}
__device__ __forceinline__ void phase_ssd_s3(const Ctx& C) {
    LAS bf16* Bs = (LAS bf16*)C.lds;
    LAS float* CB = (LAS float*)(C.lds + 65536);
    LAS float* Y = CB + 32 * 256;
    LAS float* CS = Y + 32 * 256;
    LAS float* DTs = CS + 4 * 256;
    const bf16* X = WSP(bf16, WS_XBC); const bf16* P = WSP(bf16, WS_PROJ); const float* DT = WSP(float, WS_DT); const float* ACS = WSP(float, WS_ACS); const float* ST = WSP(float, WS_ST);
    bf16* MIXIN = WSP(bf16, WS_MIXIN);
    for (int item = C.bid; item < NB * 32 * 2; item += C.G) {
        const int g = item & 1, c = (item >> 1) & 31, b = item >> 6;
        const size_t tok0 = (size_t)b * SEQ + c * 256;
        for (int e = C.tid; e < 256 * 16; e += 512) { const int l = e >> 4, k = e & 15; *(LAS v4u*)(Bs + l * 128 + k * 8) = *(const v4u*)(X + (tok0 + l) * 1024 + 512 + g * 128 + k * 8); }
        for (int e = C.tid; e < 1024; e += 512) { const int hh = e >> 8, l = e & 255; CS[e] = ACS[(tok0 + l) * 8 + g * 4 + hh]; DTs[e] = DT[(tok0 + l) * 8 + g * 4 + hh]; }
        __syncthreads();
        for (int lt = 0; lt < 8; ++lt) {
            const int l0 = lt * 32;
            { const int li = C.tid >> 4, sg = C.tid & 15, l = l0 + li;
              float acc[16];
#pragma unroll
              for (int k = 0; k < 16; ++k) acc[k] = 0.f;
              const bf16* cr = X + (tok0 + l) * 1024 + 768 + g * 128;
              for (int n8 = 0; n8 < 16; ++n8) { const v4u cv = *(const v4u*)(cr + n8 * 8);
                  const float c0 = bflo(cv.x), c1 = bfhi(cv.x), c2 = bflo(cv.y), c3 = bfhi(cv.y), c4 = bflo(cv.z), c5 = bfhi(cv.z), c6 = bflo(cv.w), c7 = bfhi(cv.w);
#pragma unroll
                  for (int k = 0; k < 16; ++k) { const v4u bv = *(const LAS v4u*)(Bs + (sg + 16 * k) * 128 + n8 * 8);
                      acc[k] += c0 * bflo(bv.x) + c1 * bfhi(bv.x) + c2 * bflo(bv.y) + c3 * bfhi(bv.y) + c4 * bflo(bv.z) + c5 * bfhi(bv.z) + c6 * bflo(bv.w) + c7 * bfhi(bv.w); } }
#pragma unroll
              for (int k = 0; k < 16; ++k) { const int s = sg + 16 * k; CB[li * 256 + s] = (s <= l) ? acc[k] : 0.f; } }
            __syncthreads();
            { const int li = C.tid >> 4, hh = (C.tid >> 2) & 3, pq = C.tid & 3, l = l0 + li, h = g * 4 + hh, ch0 = h * 64 + pq * 16;
              float acc[16];
#pragma unroll
              for (int k = 0; k < 16; ++k) acc[k] = 0.f;
              const float al = CS[hh * 256 + l];
              for (int s = 0; s <= l; ++s) { const float w = CB[li * 256 + s] * __expf(al - CS[hh * 256 + s]) * DTs[hh * 256 + s];
                  const v4u x0 = *(const v4u*)(X + (tok0 + s) * 1024 + ch0), x1 = *(const v4u*)(X + (tok0 + s) * 1024 + ch0 + 8);
                  acc[0] += w * bflo(x0.x); acc[1] += w * bfhi(x0.x); acc[2] += w * bflo(x0.y); acc[3] += w * bfhi(x0.y); acc[4] += w * bflo(x0.z); acc[5] += w * bfhi(x0.z); acc[6] += w * bflo(x0.w); acc[7] += w * bfhi(x0.w);
                  acc[8] += w * bflo(x1.x); acc[9] += w * bfhi(x1.x); acc[10] += w * bflo(x1.y); acc[11] += w * bfhi(x1.y); acc[12] += w * bflo(x1.z); acc[13] += w * bfhi(x1.z); acc[14] += w * bflo(x1.w); acc[15] += w * bfhi(x1.w); }
              { const float* pv = ST + (((size_t)(b * 32 + c) * 8 + h) * 64 + pq * 16) * 128; const bf16* cr = X + (tok0 + l) * 1024 + 768 + g * 128; const float el = __expf(al);
                float off[16];
#pragma unroll
                for (int k = 0; k < 16; ++k) off[k] = 0.f;
                for (int n4 = 0; n4 < 32; ++n4) { const v2u cv = *(const v2u*)(cr + n4 * 4); const float c0 = bflo(cv.x), c1 = bfhi(cv.x), c2 = bflo(cv.y), c3 = bfhi(cv.y);
#pragma unroll
                    for (int k = 0; k < 16; ++k) { const f32x4 pp = *(const f32x4*)(pv + k * 128 + n4 * 4); off[k] += c0 * pp.x + c1 * pp.y + c2 * pp.z + c3 * pp.w; } }
#pragma unroll
                for (int k = 0; k < 16; ++k) acc[k] += el * off[k]; }
              { const float Dh = INP(20)[h]; const bf16* xr = X + (tok0 + l) * 1024 + ch0; const bf16* zr = P + (tok0 + l) * HY_NP + C_Z + ch0;
#pragma unroll
                for (int k = 0; k < 16; ++k) { const float y = acc[k] + Dh * bf2f(xr[k]); Y[li * 256 + hh * 64 + pq * 16 + k] = y * siluf(bf2f(zr[k])); } } }
            __syncthreads();
            { const float* ng = INP(21) + g * 256;
              for (int rr = C.wave; rr < 32; rr += 8) { const f32x4 v = *(const LAS f32x4*)(Y + rr * 256 + C.lane * 4);
                  const float ss = wave_sum(v.x * v.x + v.y * v.y + v.z * v.z + v.w * v.w); const float rs = 1.f / sqrtf(ss * (1.f / 256.f) + NORM_EPS);
                  const f32x4 gg = *(const f32x4*)(ng + C.lane * 4); v2u w; w.x = pk2(v.x * rs * gg.x, v.y * rs * gg.y); w.y = pk2(v.z * rs * gg.z, v.w * rs * gg.w);
                  *(v2u*)(MIXIN + (tok0 + l0 + rr) * 1024 + 512 + g * 256 + C.lane * 4) = w; } }
            __syncthreads();
        }
    }
}
__device__ __forceinline__ float dot64_bf16(const float (&q)[64], const bf16* kr) {
    float s = 0.f;
#pragma unroll
    for (int i = 0; i < 8; ++i) { const v4u kv = *(const v4u*)(kr + i * 8);
        s += q[i * 8 + 0] * bflo(kv.x) + q[i * 8 + 1] * bfhi(kv.x) + q[i * 8 + 2] * bflo(kv.y) + q[i * 8 + 3] * bfhi(kv.y)
           + q[i * 8 + 4] * bflo(kv.z) + q[i * 8 + 5] * bfhi(kv.z) + q[i * 8 + 6] * bflo(kv.w) + q[i * 8 + 7] * bfhi(kv.w); }
    return s;
}
__device__ __forceinline__ float dot64_f32(const float (&q)[64], const float* kr) {
    float s = 0.f;
#pragma unroll
    for (int i = 0; i < 16; ++i) { const f32x4 kv = *(const f32x4*)(kr + i * 4); s += q[i * 4 + 0] * kv.x + q[i * 4 + 1] * kv.y + q[i * 4 + 2] * kv.z + q[i * 4 + 3] * kv.w; }
    return s;
}
__device__ __forceinline__ void phase_nsa(const Ctx& C) {
    LAS float* PC = (LAS float*)C.lds;
    LAS float* IMP = PC + 2 * 4 * 512;
    LAS int* SEL = (LAS int*)(IMP + 256);
    LAS float* PW = (LAS float*)(SEL + 256);
    const bf16* P = WSP(bf16, WS_PROJ); const float* KC = WSP(float, WS_KC); const float* VC = WSP(float, WS_VC); const float* side = WSP(float, WS_SIDE);
    bf16* MIXIN = WSP(bf16, WS_MIXIN);
    const int wave = C.wave, lane = C.lane, it = wave >> 2, r = wave & 3;
    LAS float* pw = PW + wave * 64;
    for (int pair = C.bid; pair < NB * 2 * (SEQ / 2); pair += C.G) {
        const int t2 = pair & (SEQ / 2 - 1), bg = pair >> 12, g = bg & 1, b = bg >> 1;
        const int t = 2 * t2 + it, h = g * 4 + r;
        const size_t tok = (size_t)b * SEQ + t;
        float q[64];
        { const bf16* qr = P + tok * HY_NP + h * 64;
#pragma unroll
          for (int i = 0; i < 8; ++i) { const v4u v = *(const v4u*)(qr + i * 8); q[i * 8 + 0] = bflo(v.x); q[i * 8 + 1] = bfhi(v.x); q[i * 8 + 2] = bflo(v.y); q[i * 8 + 3] = bfhi(v.y); q[i * 8 + 4] = bflo(v.z); q[i * 8 + 5] = bfhi(v.z); q[i * 8 + 6] = bflo(v.w); q[i * 8 + 7] = bfhi(v.w); } }
        const int ncv = t >= 31 ? (t - 15) >> 4 : 0;
        const float* kcb = KC + (size_t)(b * 2 + g) * NCMP_P * 64; const float* vcb = VC + (size_t)(b * 2 + g) * NCMP_P * 64;
        float sc[8]; float mx = -INFINITY;
#pragma unroll
        for (int i = 0; i < 8; ++i) { const int n = lane + 64 * i; float s = -INFINITY; if (n < ncv) s = dot64_f32(q, kcb + (size_t)n * 64) * 0.125f; sc[i] = s; mx = fmaxf(mx, s); }
        mx = wave_max(mx);
        float lsum = 0.f;
#pragma unroll
        for (int i = 0; i < 8; ++i) { const int n = lane + 64 * i; const float e = (n < ncv) ? __expf(sc[i] - mx) : 0.f; sc[i] = e; lsum += e; }
        lsum = wave_sum(lsum);
        const float inv = ncv > 0 ? 1.f / lsum : 0.f;
        LAS float* pc = PC + (it * 4 + r) * 512;
#pragma unroll
        for (int i = 0; i < 8; ++i) pc[lane + 64 * i] = sc[i] * inv;
        LDS_WAIT();
        float oc = 0.f;
        for (int n = 0; n < ncv; ++n) oc += pc[n] * vcb[(size_t)n * 64 + lane];
        __syncthreads();
        if (C.tid < 256) { const int it2 = C.tid >> 7, j = C.tid & 127, cur = (2 * t2 + it2) >> 6; float v = 0.f;
            const int n0 = (4 * j - 1) < 0 ? 0 : 4 * j - 1, n1 = (4 * j + 3) > (NCMP - 1) ? (NCMP - 1) : 4 * j + 3;
#pragma unroll
            for (int rr = 0; rr < 4; ++rr) for (int n = n0; n <= n1; ++n) v += PC[(it2 * 4 + rr) * 512 + n];
            const bool valid = j <= cur, forced = (j == 0) | (j == cur) | (j == cur - 1);
            IMP[it2 * 128 + j] = forced ? 1e9f : (valid ? v : -1.f); }
        __syncthreads();
        if (C.tid < 256) { const int it2 = C.tid >> 7, j = C.tid & 127, cur = (2 * t2 + it2) >> 6; const float v = IMP[it2 * 128 + j]; int cnt = 0;
            for (int jj = 0; jj < 128; ++jj) { const float u = IMP[it2 * 128 + jj]; cnt += ((u > v) || (u == v && jj < j)) ? 1 : 0; }
            SEL[it2 * 128 + j] = (cnt < 16 && j <= cur) ? 1 : 0; }
        __syncthreads();
        float ms = -INFINITY, ls = 0.f, os = 0.f;
        { const bf16* Kb = P + (size_t)b * SEQ * HY_NP + C_KV + 2 * 128 + g * 64; const bf16* Vb = P + (size_t)b * SEQ * HY_NP + C_KV + 3 * 128 + g * 64;
#pragma unroll 1
          for (int half = 0; half < 2; ++half) {
            unsigned long long mk = __ballot(SEL[it * 128 + half * 64 + lane] != 0);
            while (mk) { const int j = half * 64 + (__ffsll((long long)mk) - 1); mk &= mk - 1;
                const int key = 64 * j + lane; float s = -INFINITY;
                if (key <= t) s = dot64_bf16(q, Kb + (size_t)key * HY_NP) * 0.125f;
                const float bm = wave_max(s), mn = fmaxf(ms, bm), corr = __expf(ms - mn), p = (key <= t) ? __expf(s - mn) : 0.f;
                ls = ls * corr + wave_sum(p); os *= corr; ms = mn;
                pw[lane] = p; LDS_WAIT();
                const bf16* vr = Vb + (size_t)(64 * j) * HY_NP + lane;
#pragma unroll 8
                for (int kk = 0; kk < 64; ++kk) os += pw[kk] * bf2f(vr[(size_t)kk * HY_NP]);
                LDS_WAIT();
            } } }
        float mw = -INFINITY, lw = 0.f, ow = 0.f;
        { const bf16* Kb = P + (size_t)b * SEQ * HY_NP + C_KV + 4 * 128 + g * 64; const bf16* Vb = P + (size_t)b * SEQ * HY_NP + C_KV + 5 * 128 + g * 64;
          const int lo = t - 511 < 0 ? 0 : t - 511;
          for (int base = lo; base <= t; base += 64) {
              const int key = base + lane; float s = -INFINITY;
              if (key <= t) s = dot64_bf16(q, Kb + (size_t)key * HY_NP) * 0.125f;
              const float bm = wave_max(s), mn = fmaxf(mw, bm), corr = __expf(mw - mn), p = (key <= t) ? __expf(s - mn) : 0.f;
              lw = lw * corr + wave_sum(p); ow *= corr; mw = mn;
              pw[lane] = p; LDS_WAIT();
              const int nk = (t - base + 1) < 64 ? (t - base + 1) : 64;
              const bf16* vr = Vb + (size_t)base * HY_NP + lane;
              for (int kk = 0; kk < nk; ++kk) ow += pw[kk] * bf2f(vr[(size_t)kk * HY_NP]);
              LDS_WAIT();
          } }
        { const float* gl = side + tok * 32 + h * 3; const float g0 = sigmf(gl[0]), g1 = sigmf(gl[1]), g2 = sigmf(gl[2]);
          const float o = g0 * oc + g1 * (os / ls) + g2 * (ow / lw);
          MIXIN[tok * 1024 + h * 64 + lane] = (bf16)f2bf(o); }
        __syncthreads();
    }
}

__device__ __forceinline__ void phase_ffn_act(const Ctx& C, int layer) {
    const bf16* U = WSP(bf16, WS_U); bf16* ACT = WSP(bf16, WS_ACT);
    const float* cw = INP(29) + (size_t)layer * 3 * FF2; const float* cb = INP(30) + (size_t)layer * FF2;
    for (int idx = C.bid * 512 + C.tid; idx < SEQ * (FF / 2); idx += C.G * 512) {
        const int t = idx / (FF / 2), c = (idx - t * (FF / 2)) * 2;
        float g0 = cb[c], g1 = cb[c + 1], v0 = cb[FF + c], v1 = cb[FF + c + 1];
#pragma unroll
        for (int j = 0; j < 3; ++j) { const int tt = t - 2 + j; if (tt >= 0) { const unsigned ug = *(const unsigned*)(U + (size_t)tt * FF2 + c), uv = *(const unsigned*)(U + (size_t)tt * FF2 + FF + c);
            g0 += cw[j * FF2 + c] * bflo(ug); g1 += cw[j * FF2 + c + 1] * bfhi(ug); v0 += cw[j * FF2 + FF + c] * bflo(uv); v1 += cw[j * FF2 + FF + c + 1] * bfhi(uv); } }
        *(unsigned*)(ACT + (size_t)t * FF + c) = pk2(siluf(g0) * v0, siluf(g1) * v1);
    }
}

__device__ __forceinline__ void phase_gdn_prep(const Ctx& C) {
    const bf16* QKV = WSP(bf16, WS_QKV); const float* cw = INP(23);
    bf16* QN = WSP(bf16, WS_QN); bf16* KN = WSP(bf16, WS_KN); bf16* VN = WSP(bf16, WS_VN);
    const int gw = C.bid * 8 + C.wave, NGW = C.G * 8, lane = C.lane;
    for (int item = gw; item < NTOK * 24; item += NGW) {
        const int tok = item / 24, rem = item - tok * 24, which = rem >> 3, h = rem & 7, s = tok & (SEQ - 1);
        const int col = which * 1024 + h * 128 + lane * 2;
        float a0 = 0.f, a1 = 0.f;
#pragma unroll
        for (int j = 0; j < 4; ++j) { const int ss = s - 3 + j; if (ss >= 0) { const unsigned u = *(const unsigned*)(QKV + (size_t)(tok - 3 + j) * 3072 + col); a0 += cw[j * 3072 + col] * bflo(u); a1 += cw[j * 3072 + col + 1] * bfhi(u); } }
        a0 = siluf(a0); a1 = siluf(a1);
        if (which < 2) { const float ss = wave_sum(a0 * a0 + a1 * a1); float rs = 1.f / sqrtf(ss + NORM_EPS); if (which == 0) rs *= 0.08838834764831845f; a0 *= rs; a1 *= rs; }
        bf16* dst = which == 0 ? QN : (which == 1 ? KN : VN);
        *(unsigned*)(dst + (size_t)tok * 1024 + h * 128 + lane * 2) = pk2(a0, a1);
    }
    { const float* side = WSP(float, WS_SIDE2); float* BETA = WSP(float, WS_BETA); float* GG = WSP(float, WS_G); const float* db = INP(24); const float* al = INP(25);
      for (int idx = C.bid * 512 + C.tid; idx < NTOK * 8; idx += C.G * 512) { const int tok = idx >> 3, h = idx & 7;
          BETA[idx] = sigmf(side[(size_t)tok * 16 + h]); GG[idx] = -__expf(al[h]) * softplusf(side[(size_t)tok * 16 + 8 + h] + db[h]); } }
}
__device__ __forceinline__ void phase_gdn_rec(const Ctx& C) {
    const bf16* QN = WSP(bf16, WS_QN); const bf16* KN = WSP(bf16, WS_KN); const bf16* VN = WSP(bf16, WS_VN); const float* BETA = WSP(float, WS_BETA); const float* GG = WSP(float, WS_G);
    float* O = WSP(float, WS_O1);
    const int gw = C.bid * 8 + C.wave, NGW = C.G * 8, lane = C.lane;
    for (int item = gw; item < NB * 8 * 64; item += NGW) {
        const int ep = item & 63, h = (item >> 6) & 7, b = item >> 9, e0 = ep * 2;
        float s00 = 0.f, s01 = 0.f, s10 = 0.f, s11 = 0.f;
        const size_t base = (size_t)b * SEQ;
        for (int t = 0; t < SEQ; ++t) {
            const size_t tok = base + t;
            const unsigned ku = *(const unsigned*)(KN + tok * 1024 + h * 128 + lane * 2), qu = *(const unsigned*)(QN + tok * 1024 + h * 128 + lane * 2);
            const unsigned vu = *(const unsigned*)(VN + tok * 1024 + h * 128 + e0);
            const float k0 = bflo(ku), k1 = bfhi(ku), q0 = bflo(qu), q1 = bfhi(qu), v0 = bflo(vu), v1 = bfhi(vu);
            const float eg = __expf(GG[tok * 8 + h]), be = BETA[tok * 8 + h];
            s00 *= eg; s01 *= eg; s10 *= eg; s11 *= eg;
            const float kv0 = wave_sum(k0 * s00 + k1 * s01), kv1 = wave_sum(k0 * s10 + k1 * s11);
            const float d0 = be * (v0 - kv0), d1 = be * (v1 - kv1);
            s00 += k0 * d0; s01 += k1 * d0; s10 += k0 * d1; s11 += k1 * d1;
            const float o0 = wave_sum(q0 * s00 + q1 * s01), o1 = wave_sum(q0 * s10 + q1 * s11);
            if (lane == 0) { O[tok * 1024 + h * 128 + e0] = o0; O[tok * 1024 + h * 128 + e0 + 1] = o1; }
        }
    }
}
__device__ __forceinline__ void phase_gdn_gate(const Ctx& C) {
    const float* O = WSP(float, WS_O1); const bf16* Z = WSP(bf16, WS_Z1); bf16* GIN = WSP(bf16, WS_GIN); const float* ng = INP(26);
    const int gw = C.bid * 8 + C.wave, NGW = C.G * 8, lane = C.lane;
    for (int item = gw; item < NTOK * 8; item += NGW) {
        const size_t off = (size_t)item * 128 + lane * 2;
        const float o0 = O[off], o1 = O[off + 1];
        const float rs = 1.f / sqrtf(wave_sum(o0 * o0 + o1 * o1) * (1.f / 128.f) + NORM_EPS);
        const unsigned zu = *(const unsigned*)(Z + off);
        *(unsigned*)(GIN + off) = pk2(o0 * rs * ng[lane * 2] * siluf(bflo(zu)), o1 * rs * ng[lane * 2 + 1] * siluf(bfhi(zu)));
    }
}

constexpr int N_PHASES = 47;
#ifndef PHMASK
#define PHMASK 0xFFFFFFFFFFFFFFFFull
#endif
#define EN(k) (((PHMASK) >> (k)) & 1ull)

__global__ void __launch_bounds__(512, 2) mega_fwd(Args args) {
    extern __shared__ __attribute__((aligned(16))) unsigned char lds_raw[];
    XcdBarrier bar;
    Ctx C0;
    C0.lds = (LAS unsigned char*)lds_raw;
    C0.tid = threadIdx.x; C0.lane = C0.tid & 63; C0.wave = __builtin_amdgcn_readfirstlane(C0.tid >> 6); C0.G = gridDim.x; C0.bid = blockIdx.x;
    { const Ctx& C = C0;
    volatile LAS unsigned* MISC = (volatile LAS unsigned*)(C.lds + MISC_OFF);
    if (C.tid < 16) MISC[C.tid] = 0u;
    if (C.tid == 0) { LAS unsigned long long* pt = (LAS unsigned long long*)(C.lds + PTR_OFF);
#pragma unroll
        for (int i = 0; i < 32; ++i) pt[i] = (unsigned long long)args.in[i];
        pt[32] = (unsigned long long)args.out; pt[33] = (unsigned long long)args.ws;
        LAS float* fq = (LAS float*)(C.lds + PTR_OFF + 34 * 8);
#pragma unroll
        for (int i = 0; i < 8; ++i) fq[i] = args.ifq.f[i]; }
    __syncthreads();
    gu32* ctl = (gu32*)(ldptr(C, 33) + WS_CTL);
    bar.bar = (unsigned*)(ctl + CW_BAR); bar.x = 0; bar.st = nullptr;
    const bool multi = (args.ph_hi - args.ph_lo) > 1;
    if (multi) bar = xcd_barrier_post((unsigned*)(ctl + CW_BAR), MISC + 8);
    if (multi) { cooperative_groups::this_grid().sync(); }
    }

    const int ph_lo = args.ph_lo, ph_hi = args.ph_hi;
    for (int ph = ph_lo; ph < ph_hi; ++ph) {
        Ctx C; { int tid = threadIdx.x, bid = blockIdx.x, G = gridDim.x; asm volatile("" : "+v"(tid)); asm volatile("" : "+s"(bid)); asm volatile("" : "+s"(G));
                 C.lds = (LAS unsigned char*)lds_raw; C.tid = tid; C.lane = tid & 63; C.wave = __builtin_amdgcn_readfirstlane(tid >> 6); C.G = G; C.bid = bid; }
        if (EN(0) && ph == 0) phase_prologue(C);
        else if (EN(1) && ph == 1) { pg8::Gemm g{WSP(bf16, WS_HN), WSP(bf16, WS_W_HYIN), NTOK, HY_NP, DM}; pg8::StaticOrder S; S.init(NTOK, HY_NP, C.G, C.bid);
            EpiHyIn E{WSP(bf16, WS_PROJ), WSP(float, WS_SIDE)}; pg8::gemm_phase<EpiHyIn, pg8::StaticOrder, true, true>(C.lds, g, S, E, C.tid); }
        else if (EN(2) && ph == 2) phase_rope_conv(C);
        else if (EN(3) && ph == 3) { phase_compress(C); phase_ssd_s1(C); }
        else if (EN(4) && ph == 4) phase_ssd_s2(C);
        else if (EN(5) && ph == 5) phase_ssd_s3(C);
        else if (EN(6) && ph == 6) phase_nsa(C);
        else if (EN(7) && (ph == 7 || ph == 29)) { const bool l1 = ph == 29;
            pg8::Gemm g{l1 ? WSP(bf16, WS_GIN) : WSP(bf16, WS_MIXIN), l1 ? WSP(bf16, WS_W_GDNOUT) : WSP(bf16, WS_W_HYOUT), NTOK, DM, DM}; pg8::StaticOrder S; S.init(NTOK, DM, C.G, C.bid);
            EpiF32 E{l1 ? WSP(float, WS_MIX1) : WSP(float, WS_MIX), DM}; pg8::gemm_phase<EpiF32, pg8::StaticOrder, true, true>(C.lds, g, S, E, C.tid); }
        else if (EN(8) && ph == 8) phase_res(C, INP(0), OUTP(), WSP(float, WS_MIX), 0, NTOK, INP(3), INP(4), WSP(bf16, WS_HN));
        else if (EN(8) && ph == 30) phase_res(C, OUTP(), OUTP(), WSP(float, WS_MIX1), 0, NTOK, INP(3) + DM, INP(4) + DM, WSP(bf16, WS_HN));
        else if (EN(9) && ((ph >= 9 && ph < 25) || (ph >= 31 && ph < 47))) {
            const int layer = ph >= 31 ? 1 : 0, k = ph - (layer ? 31 : 9), b = k >> 2, step = k & 3;
            if (step == 0) { pg8::Gemm g{WSP(bf16, WS_HN) + (size_t)b * SEQ * DM, layer ? WSP(bf16, WS_W_UP1) : WSP(bf16, WS_W_UP0), SEQ, FF2, DM}; pg8::StaticOrder S; S.init(SEQ, FF2, C.G, C.bid);
                EpiB16 E{WSP(bf16, WS_U), FF2}; pg8::gemm_phase<EpiB16, pg8::StaticOrder, true, true>(C.lds, g, S, E, C.tid); }
            else if (step == 1) phase_ffn_act(C, layer);
            else if (step == 2) { pg8::Gemm g{WSP(bf16, WS_ACT), layer ? WSP(bf16, WS_W_DN1) : WSP(bf16, WS_W_DN0), SEQ, DM, FF}; pg8::StaticOrder S; S.init(SEQ, DM, C.G, C.bid);
                EpiF32 E{WSP(float, WS_F), DM}; pg8::gemm_phase<EpiF32, pg8::StaticOrder, true, true>(C.lds, g, S, E, C.tid); }
            else phase_res(C, OUTP(), OUTP(), WSP(float, WS_F), b * SEQ, SEQ, INP(5) + layer * DM, layer ? (const float*)nullptr : INP(2) + DM, WSP(bf16, WS_HN));
        }
        else if (EN(25) && ph == 25) { pg8::Gemm g{WSP(bf16, WS_HN), WSP(bf16, WS_W_GDNIN), NTOK, GDN_NP, DM}; pg8::StaticOrder S; S.init(NTOK, GDN_NP, C.G, C.bid);
            EpiGdnIn E{WSP(bf16, WS_QKV), WSP(bf16, WS_Z1), WSP(float, WS_SIDE2)}; pg8::gemm_phase<EpiGdnIn, pg8::StaticOrder, true, true>(C.lds, g, S, E, C.tid); }
        else if (EN(26) && ph == 26) phase_gdn_prep(C);
        else if (EN(27) && ph == 27) phase_gdn_rec(C);
        else if (EN(28) && ph == 28) phase_gdn_gate(C);
        if (ph + 1 < ph_hi) xcd_barrier(bar);
    }
}

extern "C" void kernel_launch(void* const* d_in, const int* in_sizes, int n_in, void* d_out, int out_size, void* d_ws, size_t ws_size, hipStream_t stream) {
    static int grid = 0;
    if (grid == 0) {
        if (n_in != 32 || in_sizes[0] != NTOK * DM || out_size != NTOK * DM || ws_size < WS_END) {
            fprintf(stderr, "kernel_launch: unexpected shapes: n_in %d in0 %d out %d ws %zu (need %zu); nothing launched\n", n_in, n_in > 0 ? in_sizes[0] : -1, out_size, ws_size, (size_t)WS_END); grid = -1; return; }
        int dev = 0, cus = 0, per_cu = 0;
        if (hipGetDevice(&dev) != hipSuccess || hipDeviceGetAttribute(&cus, hipDeviceAttributeMultiprocessorCount, dev) != hipSuccess) { grid = -1; return; }
        if (hipFuncSetAttribute((const void*)mega_fwd, hipFuncAttributeMaxDynamicSharedMemorySize, LDS_BYTES) != hipSuccess) { fprintf(stderr, "kernel_launch: hipFuncSetAttribute failed\n"); grid = -1; return; }
        if (hipOccupancyMaxActiveBlocksPerMultiprocessor(&per_cu, (const void*)mega_fwd, 512, LDS_BYTES) != hipSuccess || per_cu < 1) { fprintf(stderr, "kernel_launch: occupancy query says %d blocks per CU\n", per_cu); (void)hipGetLastError(); grid = -1; return; }
        grid = cus;
    }
    if (grid < 0) return;
    if (hipMemsetAsync((char*)d_ws + WS_CTL, 0, CTL_ZERO_BYTES, stream) != hipSuccess) { fprintf(stderr, "kernel_launch: memset failed\n"); return; }
    Args a{};
    for (int i = 0; i < 32; ++i) a.in[i] = (const float*)d_in[i];
    a.out = (float*)d_out; a.ws = (unsigned char*)d_ws;
    for (int i = 0; i < 8; ++i) a.ifq.f[i] = (float)pow(500000.0, -(double)(2 * i) / 16.0);
#if MK_ONE_LAUNCH
    a.ph_lo = 0; a.ph_hi = N_PHASES;
    void* kargs[] = {&a};
    hipError_t e = hipLaunchCooperativeKernel((const void*)mega_fwd, dim3(grid), dim3(512), kargs, LDS_BYTES, stream);
    if (e != hipSuccess) fprintf(stderr, "kernel_launch: cooperative launch failed: %s (grid %d)\n", hipGetErrorString(e), grid);
#else
    for (int ph = 0; ph < N_PHASES; ++ph) { a.ph_lo = ph; a.ph_hi = ph + 1; hipLaunchKernelGGL(mega_fwd, dim3(grid), dim3(512), LDS_BYTES, stream, a); }
#endif
}
```

```cpp
#include <hip/hip_runtime.h>
#include <hip/hip_cooperative_groups.h>
#include <cstdio>
#include <cstdint>
#ifndef MK_ONE_LAUNCH
#define MK_ONE_LAUNCH 1
#endif
namespace pg8 {
#define PG8_LAS __attribute__((address_space(3)))
typedef unsigned short bf16_t;
typedef short bf16x8 __attribute__((ext_vector_type(8)));
typedef float f32x4 __attribute__((ext_vector_type(4)));
typedef unsigned u32x4 __attribute__((ext_vector_type(4)));
constexpr int BM = 256, BK = 64, HALF = 128, HTB = HALF * BK * 2  , STAGE_BYTES = 8 * HTB, NXCD = 8, WGM = 8;

__host__ __device__ __forceinline__ int lds_byte(int r, int c) { const int st = (r >> 4) * 2 + (c >> 5), rr = r & 15, cc = c & 31, ob = rr * 64 + cc * 2; return st * 1024 + (ob ^ (((ob >> 9) & 1) << 5)); }
__host__ __device__ __forceinline__ void stage_rc(int b, int& R, int& C) { const int st = b / 1024, sb = b % 1024, swz = sb ^ (((sb >> 9) & 1) << 5); R = (st >> 1) * 16 + swz / 64; C = (st & 1) * 32 + (swz % 64) / 2; }
__host__ __device__ __forceinline__ int perm32(int rho) { const int n = rho >> 4, i = rho & 15; return 8 * (i >> 2) + 4 * n + (i & 3); }

struct Unit { int pm, pn; };
struct Gemm { const bf16_t* A; const bf16_t* Bt; int M, N, K; };

struct StaticOrder {
    int nM, nN, nwg, G, c;
    __host__ __device__ void init(int M, int N, int G_, int c_) { nM = M / BM; nN = N / BM; nwg = nM * nN; G = G_; c = c_; }
    __host__ __device__ bool next(int i, Unit& u) const {
        const long L = (long)i * G + c; if (L >= nwg) return false;
        int wgid = (int)L; { const int q = nwg / NXCD, r = nwg % NXCD, xcd = wgid % NXCD, off = wgid / NXCD; wgid = (xcd < r ? xcd * (q + 1) : r * (q + 1) + (xcd - r) * q) + off; }
        const int nig = WGM * nN, gid = wgid / nig, fm = gid * WGM, gsz = (nM - fm) < WGM ? (nM - fm) : WGM;
        u.pm = fm + ((wgid % nig) % gsz); u.pn = (wgid % nig) / gsz; return true;
    }
    __device__ __forceinline__ void a_ready(const Unit&) const {}
    __device__ __forceinline__ void done(const Unit&) const {}
};

__device__ __forceinline__ unsigned cvt_pk_bf16(float lo, float hi) { unsigned r; asm volatile("v_cvt_pk_bf16_f32 %0, %1, %2" : "=v"(r) : "v"(lo), "v"(hi)); return r; }

template <class Epi, class Sched, bool ALIGN_EPI = false, bool SP2 = false>
__device__ __forceinline__ void gemm_phase(PG8_LAS unsigned char* lds, const Gemm g, const Sched& S, const Epi& E, const int tid) {
    const int  wid = __builtin_amdgcn_readfirstlane(tid >> 6), lane = tid & 63, wr = wid >> 2, wc = wid & 3, fr = lane & 15, fq = lane >> 4;
    const int K = g.K, nt = K / BK;
    unsigned voffA[2], voffB[2];
#pragma unroll
    for (int i = 0; i < 2; ++i) { int R, C; stage_rc(tid * 16 + i * 8192, R, C); const int Rb = Epi::PERM ? ((R & ~31) + perm32(R & 31)) : R;
        voffA[i] = (unsigned)(R * K + C) * 2u; voffB[i] = (unsigned)(Rb * K + C) * 2u; }
    const size_t kstep = (size_t)(BK * 2);
    const size_t hstep = (size_t)HALF * K * 2;
    const size_t tstep = 2 * hstep;
    const unsigned ldsw = (unsigned)wid * 1024u;
    const int aoff = lds_byte(wr * 64 + fr, fq * 8), boff = lds_byte(wc * 32 + fr, fq * 8);
#define PG8_SA(b, h) (((b) * 2 + (h)) * HTB)
#define PG8_SB(b, h) ((4 + (b) * 2 + (h)) * HTB)
#define PG8_STAGE(bufoff, gbase, voff) do { _Pragma("unroll") for (int _i = 0; _i < 2; ++_i) \
        __builtin_amdgcn_global_load_lds((const unsigned*)((const char*)(gbase) + (voff)[_i]), (PG8_LAS unsigned*)(lds + (bufoff) + ldsw + _i * 8192), 16, 0, 0); } while (0)
#define PG8_LDA(dst, b, h) do { _Pragma("unroll") for (int m = 0; m < 4; ++m) _Pragma("unroll") for (int k = 0; k < 2; ++k) dst[m][k] = *(const PG8_LAS bf16x8*)(lds + PG8_SA(b, h) + aoff + m * 2048 + k * 1024); } while (0)
#define PG8_LDB(dst, b, h) do { _Pragma("unroll") for (int n = 0; n < 2; ++n) _Pragma("unroll") for (int k = 0; k < 2; ++k) dst[n][k] = *(const PG8_LAS bf16x8*)(lds + PG8_SB(b, h) + boff + n * 2048 + k * 1024); } while (0)
#define PG8_MMA(ai, bj, At, Bt) do { __builtin_amdgcn_s_setprio(1); _Pragma("unroll") for (int m = 0; m < 4; ++m) _Pragma("unroll") for (int n = 0; n < 2; ++n) _Pragma("unroll") for (int k = 0; k < 2; ++k) \
        acc[ai][bj][m][n] = __builtin_amdgcn_mfma_f32_16x16x32_bf16(Bt[n][k], At[m][k], acc[ai][bj][m][n], 0, 0, 0); __builtin_amdgcn_s_setprio(0); } while (0)
#define PG8_WAIT_V(n) asm volatile("s_waitcnt vmcnt(" #n ")" ::: "memory")
#define PG8_WAIT_L(n) asm volatile("s_waitcnt lgkmcnt(" #n ")" ::: "memory")
#define PG8_BAR __builtin_amdgcn_s_barrier()
#define PG8_SCHED __builtin_amdgcn_sched_barrier(0)
    Unit cur, nxt; int ui = 0;
    if (!S.next(0, cur)) return;
    f32x4 acc[2][2][4][2];
#pragma unroll
    for (int a = 0; a < 2; ++a)
#pragma unroll
        for (int b = 0; b < 2; ++b)
#pragma unroll
            for (int m = 0; m < 4; ++m)
#pragma unroll
                for (int n = 0; n < 2; ++n) acc[a][b][m][n] = (f32x4){0.f, 0.f, 0.f, 0.f};
    bf16x8 At[4][2], B0[2][2], B1[2][2];
    const char* cA = (const char*)g.A + (size_t)cur.pm * tstep; const char* cB = (const char*)g.Bt + (size_t)cur.pn * tstep;
    S.a_ready(cur);
    if constexpr (SP2) {
        PG8_STAGE(PG8_SB(0, 0), cB, voffB); PG8_STAGE(PG8_SB(0, 1), cB + hstep, voffB); PG8_STAGE(PG8_SA(0, 0), cA, voffA); PG8_STAGE(PG8_SA(0, 1), cA + hstep, voffA);
        if (wr == 1) PG8_BAR;
        PG8_WAIT_V(2); PG8_BAR;
        PG8_STAGE(PG8_SB(1, 0), cB + kstep, voffB); PG8_STAGE(PG8_SA(1, 0), cA + kstep, voffA); PG8_STAGE(PG8_SB(1, 1), cB + hstep + kstep, voffB);
        PG8_WAIT_V(6); PG8_BAR;
    } else {
        PG8_STAGE(PG8_SB(0, 0), cB, voffB); PG8_STAGE(PG8_SA(0, 0), cA, voffA); PG8_STAGE(PG8_SB(0, 1), cB + hstep, voffB); PG8_STAGE(PG8_SA(0, 1), cA + hstep, voffA);
        if (wr == 1) PG8_BAR;
        PG8_WAIT_V(4); PG8_BAR;
        PG8_STAGE(PG8_SB(1, 0), cB + kstep, voffB); PG8_STAGE(PG8_SA(1, 0), cA + kstep, voffA); PG8_STAGE(PG8_SB(1, 1), cB + hstep + kstep, voffB);
        PG8_WAIT_V(6); PG8_BAR;
    }
    for (;;) {
        const bool has_next = S.next(ui + 1, nxt);
        const char* nA = has_next ? (const char*)g.A + (size_t)nxt.pm * tstep : cA; const char* nB = has_next ? (const char*)g.Bt + (size_t)nxt.pn * tstep : cB;
        for (int t = 0; t < nt; t += 2) {
            const bool last = (t == nt - 2);
            const char* a1 = cA + (size_t)(t + 1) * kstep;
            const char* a2 = last ? nA : cA + (size_t)(t + 2) * kstep; const char* b2 = last ? nB : cB + (size_t)(t + 2) * kstep;
            const char* a3 = a2 + kstep; const char* b3 = b2 + kstep;
            if (last && has_next) S.a_ready(nxt);
            if constexpr (SP2) {
            PG8_LDB(B0, 0, 0); PG8_LDB(B1, 0, 1); PG8_SCHED; PG8_LDA(At, 0, 0); PG8_STAGE(PG8_SA(1, 1), a1 + hstep, voffA);
            PG8_WAIT_V(8); PG8_WAIT_L(0); PG8_BAR; PG8_MMA(0, 0, At, B0); PG8_MMA(0, 1, At, B1); PG8_BAR; PG8_SCHED;
            PG8_LDA(At, 0, 1); PG8_STAGE(PG8_SB(0, 0), b2, voffB); PG8_STAGE(PG8_SB(0, 1), b2 + hstep, voffB); PG8_STAGE(PG8_SA(0, 0), a2, voffA);
            PG8_WAIT_V(8); PG8_WAIT_L(0); PG8_BAR; PG8_MMA(1, 0, At, B0); PG8_MMA(1, 1, At, B1); PG8_BAR; PG8_SCHED;
            PG8_LDB(B0, 1, 0); PG8_LDB(B1, 1, 1); PG8_SCHED; PG8_LDA(At, 1, 0); PG8_STAGE(PG8_SA(0, 1), a2 + hstep, voffA);
            PG8_WAIT_V(8); PG8_WAIT_L(0); PG8_BAR; PG8_MMA(0, 0, At, B0); PG8_MMA(0, 1, At, B1); PG8_BAR; PG8_SCHED;
            PG8_LDA(At, 1, 1); PG8_STAGE(PG8_SB(1, 0), b3, voffB); PG8_STAGE(PG8_SB(1, 1), b3 + hstep, voffB); PG8_STAGE(PG8_SA(1, 0), a3, voffA);
            PG8_WAIT_V(8); PG8_WAIT_L(0); PG8_BAR; PG8_MMA(1, 0, At, B0); PG8_MMA(1, 1, At, B1); PG8_BAR; PG8_SCHED;
            } else {
            PG8_LDB(B0, 0, 0); PG8_SCHED; PG8_LDA(At, 0, 0); PG8_STAGE(PG8_SA(1, 1), a1 + hstep, voffA);
            PG8_WAIT_L(8); PG8_BAR; PG8_WAIT_L(0); PG8_MMA(0, 0, At, B0); PG8_BAR; PG8_SCHED;
            PG8_LDB(B1, 0, 1); PG8_STAGE(PG8_SB(0, 0), b2, voffB);
            PG8_BAR; PG8_WAIT_L(0); PG8_MMA(0, 1, At, B1); PG8_BAR;
            PG8_LDA(At, 0, 1); PG8_STAGE(PG8_SA(0, 0), a2, voffA);
            PG8_BAR; PG8_WAIT_L(0); PG8_MMA(1, 0, At, B0); PG8_BAR; PG8_SCHED;
            PG8_STAGE(PG8_SB(0, 1), b2 + hstep, voffB);
            PG8_WAIT_V(6); PG8_BAR; PG8_MMA(1, 1, At, B1); PG8_BAR;
            PG8_LDB(B0, 1, 0); PG8_SCHED; PG8_LDA(At, 1, 0); PG8_STAGE(PG8_SA(0, 1), a2 + hstep, voffA);
            PG8_WAIT_L(8); PG8_BAR; PG8_WAIT_L(0); PG8_MMA(0, 0, At, B0); PG8_BAR; PG8_SCHED;
            PG8_LDB(B1, 1, 1); PG8_STAGE(PG8_SB(1, 0), b3, voffB);
            PG8_BAR; PG8_WAIT_L(0); PG8_MMA(0, 1, At, B1); PG8_BAR;
            PG8_LDA(At, 1, 1); PG8_STAGE(PG8_SA(1, 0), a3, voffA);
            PG8_BAR; PG8_WAIT_L(0); PG8_MMA(1, 0, At, B0); PG8_BAR; PG8_SCHED;
            PG8_STAGE(PG8_SB(1, 1), b3 + hstep, voffB);
            PG8_WAIT_V(6); PG8_BAR; PG8_MMA(1, 1, At, B1); PG8_BAR;
            }
        }
        if constexpr (ALIGN_EPI) { if (wr == 0) PG8_BAR; }
        if constexpr (!Epi::AFTER_DRAIN) { E(acc, cur, wr, wc, fr, fq); S.done(cur); }
        if (!has_next) break;
#pragma unroll
        for (int a = 0; a < 2; ++a)
#pragma unroll
            for (int b = 0; b < 2; ++b)
#pragma unroll
                for (int m = 0; m < 4; ++m)
#pragma unroll
                    for (int n = 0; n < 2; ++n) acc[a][b][m][n] = (f32x4){0.f, 0.f, 0.f, 0.f};
        cur = nxt; cA = nA; cB = nB; ++ui;
        if constexpr (ALIGN_EPI) { if (wr == 1) PG8_BAR; }
    }
    PG8_WAIT_V(0);
    if constexpr (!ALIGN_EPI) { if (wr == 0) PG8_BAR; }
    PG8_BAR;
    if constexpr (Epi::AFTER_DRAIN) { E.fused(acc, cur, wr, wc, fr, fq, lds, wid, lane); S.done(cur); }
#undef PG8_SA
#undef PG8_SB
#undef PG8_STAGE
#undef PG8_LDA
#undef PG8_LDB
#undef PG8_MMA
#undef PG8_WAIT_V
#undef PG8_WAIT_L
#undef PG8_BAR
#undef PG8_SCHED
}
}
constexpr int NB = 4, SEQ = 8192, DM = 1024, NTOK = NB * SEQ;
constexpr int HY_N = 2848, HY_NP = 3072;
constexpr int C_KV = 512, C_GATE = 1280, C_Z = 1304, C_XBC = 1816, C_DT = 2840;
constexpr int GDN_N = 4112, GDN_NP = 4352;
constexpr int FF = 2816, FF2 = 5632;
constexpr int NCMP = 511, NCMP_P = 512;
constexpr float NORM_EPS = 1e-6f;

constexpr size_t MiB = 1u << 20;
constexpr size_t WS_CTL = 0, CTL_ZERO_BYTES = 1 * MiB;
constexpr size_t WS_W_HYIN = 1 * MiB, WS_W_HYOUT = 7 * MiB, WS_W_GDNIN = 9 * MiB, WS_W_GDNOUT = 18 * MiB;
constexpr size_t WS_W_UP0 = 20 * MiB, WS_W_UP1 = 31 * MiB, WS_W_DN0 = 42 * MiB, WS_W_DN1 = 48 * MiB;
constexpr size_t WS_ROPE = 54 * MiB;
constexpr size_t WS_HN = 56 * MiB;
constexpr size_t WS_PROJ = 120 * MiB;
constexpr size_t WS_SIDE = 312 * MiB;
constexpr size_t WS_XBC = 316 * MiB;
constexpr size_t WS_MIXIN = 380 * MiB;
constexpr size_t WS_DT = 444 * MiB;
constexpr size_t WS_ACS = 445 * MiB;
constexpr size_t WS_ST = 446 * MiB;
constexpr size_t WS_KC = 478 * MiB, WS_VC = 479 * MiB;
constexpr size_t WS_MIX = 120 * MiB;
constexpr size_t WS_U = 120 * MiB;
constexpr size_t WS_ACT = 208 * MiB;
constexpr size_t WS_F = 252 * MiB;
constexpr size_t WS_QKV = 120 * MiB;
constexpr size_t WS_Z1 = 312 * MiB;
constexpr size_t WS_SIDE2 = 376 * MiB;
constexpr size_t WS_QN = 56 * MiB;
constexpr size_t WS_KN = 378 * MiB, WS_VN = 442 * MiB;
constexpr size_t WS_BETA = 506 * MiB, WS_G = 507 * MiB;
constexpr size_t WS_O1 = 120 * MiB;
constexpr size_t WS_GIN = 248 * MiB;
constexpr size_t WS_MIX1 = 312 * MiB;
constexpr size_t WS_END = 508 * MiB;
constexpr int CW_BAR = 4096;

constexpr int LDS_BYTES = 147456;
constexpr int MISC_OFF = 146944;
constexpr int PTR_OFF = MISC_OFF + 64;

#define GAS __attribute__((address_space(1)))
#define LAS __attribute__((address_space(3)))
typedef unsigned short bf16;
typedef unsigned v4u __attribute__((ext_vector_type(4)));
typedef unsigned v2u __attribute__((ext_vector_type(2)));
typedef float f32x4 __attribute__((ext_vector_type(4)));
typedef GAS unsigned gu32;
#define RLX_AGENT __ATOMIC_RELAXED, __HIP_MEMORY_SCOPE_AGENT
#define LDS_WAIT() asm volatile("s_waitcnt lgkmcnt(0)" ::: "memory")
#define VM_WAIT() asm volatile("s_waitcnt vmcnt(0)" ::: "memory")
__device__ __forceinline__ unsigned f2bf(float f) { unsigned u = __builtin_bit_cast(unsigned, f); return (u + 0x7fffu + ((u >> 16) & 1u)) >> 16; }
__device__ __forceinline__ unsigned pk2(float lo, float hi) { return f2bf(lo) | (f2bf(hi) << 16); }
__device__ __forceinline__ float bf2f(unsigned short v) { return __builtin_bit_cast(float, ((unsigned)v) << 16); }
__device__ __forceinline__ float bflo(unsigned u) { return __builtin_bit_cast(float, u << 16); }
__device__ __forceinline__ float bfhi(unsigned u) { return __builtin_bit_cast(float, u & 0xffff0000u); }
template <int CTRL> __device__ __forceinline__ float dppf(float v) { return __builtin_bit_cast(float, __builtin_amdgcn_update_dpp(0, __builtin_bit_cast(int, v), CTRL, 0xF, 0xF, false)); }
template <int CTRL> __device__ __forceinline__ unsigned dppu(unsigned v) { return (unsigned)__builtin_amdgcn_update_dpp(0, (int)v, CTRL, 0xF, 0xF, false); }
#define DPP_XOR1 0xB1
#define DPP_XOR2 0x4E
#define DPP_ROR4 0x124
#define DPP_ROR8 0x128
__device__ __forceinline__ void swap16(float v, float& a, float& b) { const unsigned u = __builtin_bit_cast(unsigned, v); auto r = __builtin_amdgcn_permlane16_swap(u, u, false, false); const unsigned r0 = r[0], r1 = r[1]; a = __builtin_bit_cast(float, r0); b = __builtin_bit_cast(float, r1); }
__device__ __forceinline__ void swap32(float v, float& a, float& b) { const unsigned u = __builtin_bit_cast(unsigned, v); auto r = __builtin_amdgcn_permlane32_swap(u, u, false, false); const unsigned r0 = r[0], r1 = r[1]; a = __builtin_bit_cast(float, r0); b = __builtin_bit_cast(float, r1); }
__device__ __forceinline__ float x16_sum(float v) { float a, b; swap16(v, a, b); return a + b; }
__device__ __forceinline__ float x32_sum(float v) { float a, b; swap32(v, a, b); return a + b; }
__device__ __forceinline__ float x16_max(float v) { float a, b; swap16(v, a, b); return fmaxf(a, b); }
__device__ __forceinline__ float x32_max(float v) { float a, b; swap32(v, a, b); return fmaxf(a, b); }
__device__ __forceinline__ float row_sum16(float v) { v += dppf<DPP_XOR1>(v); v += dppf<DPP_XOR2>(v); v += dppf<DPP_ROR4>(v); v += dppf<DPP_ROR8>(v); return v; }
__device__ __forceinline__ float wave_sum(float v) { v = row_sum16(v); v = x16_sum(v); return x32_sum(v); }
__device__ __forceinline__ float wave_max(float v) { v = fmaxf(v, dppf<DPP_XOR1>(v)); v = fmaxf(v, dppf<DPP_XOR2>(v)); v = fmaxf(v, dppf<DPP_ROR4>(v)); v = fmaxf(v, dppf<DPP_ROR8>(v)); v = x16_max(v); return x32_max(v); }
__device__ __forceinline__ float siluf(float x) { return x / (1.f + __expf(-x)); }
__device__ __forceinline__ float sigmf(float x) { return 1.f / (1.f + __expf(-x)); }
__device__ __forceinline__ float softplusf(float x) { return fmaxf(x, 0.f) + log1pf(__expf(-fabsf(x))); }
#define XB_TMO      128
#define XB_XCNT(j)  (256  + 64 * (j))
#define XB_XSUB(j)  (1280 + 64 * (j))
#define XB_XGEN(j)  (2304 + 64 * (j))
#define XB_TOP      3328
#define XB_TOPGEN   3392
#define XCD_BAR_WORDS 3456
#define XB_SPIN_CAP (1u << 18)

__device__ __forceinline__ unsigned xb_ld(unsigned* p)              { return __hip_atomic_load(p, __ATOMIC_RELAXED, __HIP_MEMORY_SCOPE_AGENT); }
__device__ __forceinline__ unsigned xb_add(unsigned* p, unsigned v) { return __hip_atomic_fetch_add(p, v, __ATOMIC_RELAXED, __HIP_MEMORY_SCOPE_AGENT); }
__device__ __forceinline__ unsigned xb_xcc_id() { return (unsigned)__builtin_amdgcn_s_getreg((3 << 11) | 20) & 0xFu; }
#define XB_SPIN(cond, bar) do { unsigned _sp = 0; while (cond) { __builtin_amdgcn_s_sleep(1); \
    if ((++_sp & 255u) == 0u) { if (xb_ld(&(bar)[XB_TMO])) break; if (_sp > XB_SPIN_CAP) { atomicAdd(&(bar)[XB_TMO], 1u); break; } } } } while (0)

struct XcdBarrier {
    unsigned* bar; unsigned x;
    volatile LAS unsigned* st;
};

__device__ __forceinline__ XcdBarrier xcd_barrier_post(unsigned* bar, volatile LAS unsigned* st) {
    XcdBarrier b; b.bar = bar; b.x = xb_xcc_id(); b.st = st;
    if (threadIdx.x == 0) (void)xb_add(&bar[XB_XCNT(b.x)], 1u);
    return b;
}
__device__ __forceinline__ void xcd_barrier_complete(unsigned* bar, unsigned x, unsigned& nloc, unsigned& nx) {
    const unsigned G = gridDim.x * gridDim.y * gridDim.z;
    unsigned sum, cnt, mine, sp = 0u;
    for (;;) {
        sum = 0u; cnt = 0u; mine = 0u;
#pragma unroll
        for (unsigned j = 0; j < 16; ++j) { const unsigned c = xb_ld(&bar[XB_XCNT(j)]); sum += c; cnt += (c > 0u) ? 1u : 0u; mine = (j == x) ? c : mine; }
        if (sum == G) break;
        __builtin_amdgcn_s_sleep(1);
        if ((++sp & 255u) == 0u) { if (xb_ld(&bar[XB_TMO])) break; if (sp > XB_SPIN_CAP) { atomicAdd(&bar[XB_TMO], 1u); break; } }
    }
    nloc = mine > 0u ? mine : 1u; nx = cnt > 0u ? cnt : 1u;
}

__device__ __forceinline__ void xcd_barrier(const XcdBarrier& b) {
    asm volatile("s_waitcnt vmcnt(0)" ::: "memory");
    __syncthreads();
    if (threadIdx.x == 0) {
        unsigned* bar = b.bar;
        __builtin_amdgcn_s_waitcnt(0);
        unsigned nloc = b.st[0], nx = b.st[1];
        if (nloc == 0u) { xcd_barrier_complete(bar, b.x, nloc, nx); b.st[0] = nloc; b.st[1] = nx; }
        const unsigned old = xb_add(&bar[XB_XSUB(b.x)], 1u);
        const unsigned gen = old / nloc;
        if (old + 1u == (gen + 1u) * nloc) {
            __builtin_amdgcn_fence(__ATOMIC_RELEASE, "agent");
            asm volatile("s_waitcnt vmcnt(0)" ::: "memory");
            const unsigned og = xb_add(&bar[XB_TOP], 1u);
            const unsigned tg = og / nx;
            if (og + 1u == (tg + 1u) * nx) xb_add(&bar[XB_TOPGEN], 1u);
            else XB_SPIN(xb_ld(&bar[XB_TOPGEN]) == tg, bar);
            __builtin_amdgcn_fence(__ATOMIC_ACQUIRE, "agent");
            xb_add(&bar[XB_XGEN(b.x)], 1u);
            asm volatile("s_waitcnt vmcnt(0)" ::: "memory");
        } else {
            XB_SPIN(xb_ld(&bar[XB_XGEN(b.x)]) == gen, bar);
            __builtin_amdgcn_fence(__ATOMIC_ACQUIRE, "agent");
            asm volatile("s_waitcnt vmcnt(0)" ::: "memory");
        }
    }
    __syncthreads();
}

#define EPI_LOOP(BODY) \
    _Pragma("unroll") for (int ai = 0; ai < 2; ++ai) _Pragma("unroll") for (int m = 0; m < 4; ++m) { const int row = u.pm * 256 + ai * 128 + wr * 64 + m * 16 + fr; \
    _Pragma("unroll") for (int bj = 0; bj < 2; ++bj) _Pragma("unroll") for (int n = 0; n < 2; ++n) { const int col = u.pn * 256 + bj * 128 + wc * 32 + n * 16 + 4 * fq; const f32x4 v = acc[ai][bj][m][n]; BODY } }

struct EpiF32 {
    static constexpr bool PERM = false, AFTER_DRAIN = false;
    float* O; int ldc;
    __device__ __forceinline__ void operator()(const pg8::f32x4 (&acc)[2][2][4][2], const pg8::Unit& u, int wr, int wc, int fr, int fq) const {
        EPI_LOOP( *(f32x4*)(O + (size_t)row * ldc + col) = v; )
    }
};
struct EpiB16 {
    static constexpr bool PERM = false, AFTER_DRAIN = false;
    bf16* O; int ldc;
    __device__ __forceinline__ void operator()(const pg8::f32x4 (&acc)[2][2][4][2], const pg8::Unit& u, int wr, int wc, int fr, int fq) const {
        EPI_LOOP( v2u w; w.x = pk2(v[0], v[1]); w.y = pk2(v[2], v[3]); *(v2u*)(O + (size_t)row * ldc + col) = w; )
    }
};
struct EpiHyIn {
    static constexpr bool PERM = false, AFTER_DRAIN = false;
    bf16* P; float* side;
    __device__ __forceinline__ void operator()(const pg8::f32x4 (&acc)[2][2][4][2], const pg8::Unit& u, int wr, int wc, int fr, int fq) const {
        EPI_LOOP( v2u w; w.x = pk2(v[0], v[1]); w.y = pk2(v[2], v[3]); *(v2u*)(P + (size_t)row * HY_NP + col) = w;
                  if (col >= C_GATE && col < C_Z) *(f32x4*)(side + (size_t)row * 32 + (col - C_GATE)) = v;
                  if (col >= C_DT && col < HY_N) *(f32x4*)(side + (size_t)row * 32 + 24 + (col - C_DT)) = v; )
    }
};
struct EpiGdnIn {
    static constexpr bool PERM = false, AFTER_DRAIN = false;
    bf16* QKV; bf16* Z; float* side;
    __device__ __forceinline__ void operator()(const pg8::f32x4 (&acc)[2][2][4][2], const pg8::Unit& u, int wr, int wc, int fr, int fq) const {
        EPI_LOOP( if (col < 3072) { v2u w; w.x = pk2(v[0], v[1]); w.y = pk2(v[2], v[3]); *(v2u*)(QKV + (size_t)row * 3072 + col) = w; }
                  else if (col < 4096) { v2u w; w.x = pk2(v[0], v[1]); w.y = pk2(v[2], v[3]); *(v2u*)(Z + (size_t)row * 1024 + (col - 3072)) = w; }
                  else if (col < GDN_N) *(f32x4*)(side + (size_t)row * 16 + (col - 4096)) = v; )
    }
};

struct InvFreq { float f[8]; };
struct Args { const float* in[32]; float* out; unsigned char* ws; int ph_lo, ph_hi; InvFreq ifq; };
struct Ctx {
    LAS unsigned char* lds;
    int tid, lane, wave, G, bid;
};
__device__ __forceinline__ unsigned char* ldptr(const Ctx& C, int k) {
    const LAS unsigned* t = (const LAS unsigned*)(C.lds + PTR_OFF) + 2 * k;
    const unsigned lo = __builtin_amdgcn_readfirstlane(t[0]), hi = __builtin_amdgcn_readfirstlane(t[1]);
    return (unsigned char*)(GAS unsigned char*)(((unsigned long long)hi << 32) | (unsigned long long)lo);
}
#define WSP(T, off) ((T*)(ldptr(C, 33) + (off)))
#define INP(k) ((const float*)ldptr(C, (k)))
#define OUTP() ((float*)ldptr(C, 32))

__device__ __forceinline__ void wt_item(const float* W, int K, int N, bf16* WT, LAS float* scr, int item, int lane, int nblk) {
    const int kb = item / nblk, nb = item % nblk, k0 = 64 * kb, n0 = 32 * nb;
    const int nn = n0 + (lane & 31); const bool ok = nn < N;
#pragma unroll 8
    for (int i = 0; i < 32; ++i) { const int kk = 2 * i + (lane >> 5); scr[kk * 33 + (lane & 31)] = ok ? W[(size_t)(k0 + kk) * N + nn] : 0.f; }
    LDS_WAIT();
    const int c = lane & 7;
#pragma unroll
    for (int j = 0; j < 4; ++j) { const int n = (lane >> 3) + 8 * j; const LAS float* s = scr + (8 * c) * 33 + n;
        v4u o; o.x = pk2(s[0 * 33], s[1 * 33]); o.y = pk2(s[2 * 33], s[3 * 33]); o.z = pk2(s[4 * 33], s[5 * 33]); o.w = pk2(s[6 * 33], s[7 * 33]);
        *(v4u*)(WT + (size_t)(n0 + n) * K + k0 + 8 * c) = o; }
    LDS_WAIT();
}
__device__ __forceinline__ void wt_matrix(const Ctx& C, const float* W, int K, int N, int Np, bf16* WT) {
    LAS float* scr = (LAS float*)(C.lds + C.wave * 16384);
    const int gw = C.bid * 8 + C.wave, NGW = C.G * 8, nblk = Np / 32, items = (K / 64) * nblk;
    for (int it = gw; it < items; it += NGW) wt_item(W, K, N, WT, scr, it, C.lane, nblk);
}
__device__ __forceinline__ void rms_row_to_bf16(const float* xrow, const float* g, bf16* orow, int lane) {
    const f32x4* xr = (const f32x4*)xrow + lane; const f32x4* gr = (const f32x4*)g + lane;
    f32x4 v[4]; float s = 0.f;
#pragma unroll
    for (int j = 0; j < 4; ++j) { v[j] = xr[64 * j]; s += (v[j].x * v[j].x + v[j].y * v[j].y) + (v[j].z * v[j].z + v[j].w * v[j].w); }
    const float rs = 1.f / sqrtf(wave_sum(s) * (1.f / DM) + NORM_EPS);
    v2u* o8 = (v2u*)orow + lane;
#pragma unroll
    for (int j = 0; j < 4; ++j) { const f32x4 gg = gr[64 * j]; v2u w; w.x = pk2(v[j].x * rs * gg.x, v[j].y * rs * gg.y); w.y = pk2(v[j].z * rs * gg.z, v[j].w * rs * gg.w); o8[64 * j] = w; }
}
__device__ __forceinline__ void sincos_acc(float af, float& sn, float& cs) {
    const double a = (double)af;
    const double q = rint(a * 0.63661977236758134308);
    double r = fma(-q, 1.57079632679489655800e+00, a); r = fma(-q, 6.12323399573676603587e-17, r);
    const int n = ((int)q) & 3;
    const double r2 = r * r;
    double s = -1.0 / 6227020800.0; s = s * r2 + 1.0 / 39916800.0; s = s * r2 - 1.0 / 362880.0; s = s * r2 + 1.0 / 5040.0; s = s * r2 - 1.0 / 120.0; s = s * r2 + 1.0 / 6.0; s = r - r * r2 * s;
    double c = 1.0 / 87178291200.0; c = c * r2 - 1.0 / 479001600.0; c = c * r2 + 1.0 / 3628800.0; c = c * r2 - 1.0 / 40320.0; c = c * r2 + 1.0 / 720.0; c = c * r2 - 1.0 / 24.0; c = c * r2 + 0.5; c = 1.0 - r2 * c;
    double so, co;
    if (n == 0) { so = s; co = c; } else if (n == 1) { so = c; co = -s; } else if (n == 2) { so = -s; co = -c; } else { so = -c; co = s; }
    sn = (float)so; cs = (float)co;
}
__device__ __forceinline__ void phase_prologue(const Ctx& C) {
    const LAS float* ifq = (const LAS float*)(C.lds + PTR_OFF + 34 * 8);
    wt_matrix(C, INP(6), DM, HY_N, HY_NP, WSP(bf16, WS_W_HYIN));
    wt_matrix(C, INP(7), DM, DM, DM, WSP(bf16, WS_W_HYOUT));
    wt_matrix(C, INP(22), DM, GDN_N, GDN_NP, WSP(bf16, WS_W_GDNIN));
    wt_matrix(C, INP(27), DM, DM, DM, WSP(bf16, WS_W_GDNOUT));
    wt_matrix(C, INP(28), DM, FF2, FF2, WSP(bf16, WS_W_UP0));
    wt_matrix(C, INP(28) + (size_t)DM * FF2, DM, FF2, FF2, WSP(bf16, WS_W_UP1));
    wt_matrix(C, INP(31), FF, DM, DM, WSP(bf16, WS_W_DN0));
    wt_matrix(C, INP(31) + (size_t)FF * DM, FF, DM, DM, WSP(bf16, WS_W_DN1));
    { const int* pos = (const int*)INP(1); float* tab = WSP(float, WS_ROPE);
      for (int idx = C.bid * 512 + C.tid; idx < NTOK * 8; idx += C.G * 512) { const int tok = idx >> 3, i = idx & 7;
          float fr = ifq[0];
#pragma unroll
          for (int k = 1; k < 8; ++k) fr = (i == k) ? ifq[k] : fr;
          const float ang = (float)pos[tok] * fr; float sn, cs; sincos_acc(ang, sn, cs); tab[tok * 16 + i] = cs; tab[tok * 16 + 8 + i] = sn; } }
    { const int gw = C.bid * 8 + C.wave, NGW = C.G * 8; bf16* HN = WSP(bf16, WS_HN);
      for (int m = gw; m < NTOK; m += NGW) rms_row_to_bf16(INP(0) + (size_t)m * DM, INP(2), HN + (size_t)m * DM, C.lane); }
}

__device__ __forceinline__ void phase_res(const Ctx& C, const float* xin, float* xout, const float* mix, int row0, int nrows, const float* gpost, const float* gnext, bf16* HN) {
    const int gw = C.bid * 8 + C.wave, NGW = C.G * 8, lane = C.lane;
    for (int r = gw; r < nrows; r += NGW) {
        const size_t grow = (size_t)(row0 + r);
        const f32x4* mr = (const f32x4*)(mix + (size_t)r * DM) + lane; const f32x4* xr = (const f32x4*)(xin + grow * DM) + lane;
        f32x4 v[4]; float s = 0.f;
#pragma unroll
        for (int j = 0; j < 4; ++j) { v[j] = mr[64 * j]; s += (v[j].x * v[j].x + v[j].y * v[j].y) + (v[j].z * v[j].z + v[j].w * v[j].w); }
        const float rs = 1.f / sqrtf(wave_sum(s) * (1.f / DM) + NORM_EPS);
        float s2 = 0.f;
#pragma unroll
        for (int j = 0; j < 4; ++j) { const f32x4 gg = ((const f32x4*)gpost + lane)[64 * j]; const f32x4 xx = xr[64 * j];
            v[j].x = xx.x + v[j].x * rs * gg.x; v[j].y = xx.y + v[j].y * rs * gg.y; v[j].z = xx.z + v[j].z * rs * gg.z; v[j].w = xx.w + v[j].w * rs * gg.w;
            s2 += (v[j].x * v[j].x + v[j].y * v[j].y) + (v[j].z * v[j].z + v[j].w * v[j].w);
            ((f32x4*)(xout + grow * DM) + lane)[64 * j] = v[j]; }
        if (gnext) { const float rs2 = 1.f / sqrtf(wave_sum(s2) * (1.f / DM) + NORM_EPS); v2u* o8 = (v2u*)(HN + grow * DM) + lane;
#pragma unroll
            for (int j = 0; j < 4; ++j) { const f32x4 gg = ((const f32x4*)gnext + lane)[64 * j]; v2u w; w.x = pk2(v[j].x * rs2 * gg.x, v[j].y * rs2 * gg.y); w.y = pk2(v[j].z * rs2 * gg.z, v[j].w * rs2 * gg.w); o8[64 * j] = w; } }
    }
}

__device__ __forceinline__ void phase_rope_conv(const Ctx& C) {
    bf16* P = WSP(bf16, WS_PROJ); const float* tab = WSP(float, WS_ROPE);
    const int gt = C.bid * 512 + C.tid, NT = C.G * 512;
    for (int idx = gt; idx < NTOK * 112; idx += NT) {
        const int tok = idx / 112, rem = idx - tok * 112, hd = rem >> 3, i = rem & 7;
        const int col0 = hd < 8 ? hd * 64 : C_KV + ((hd - 8) >> 1) * 256 + ((hd - 8) & 1) * 64;
        bf16* p = P + (size_t)tok * HY_NP + col0 + i;
        const float x1 = bf2f(p[0]), x2 = bf2f(p[8]), cs = tab[tok * 16 + i], sn = tab[tok * 16 + 8 + i];
        p[0] = (bf16)f2bf(x1 * cs - x2 * sn); p[8] = (bf16)f2bf(x2 * cs + x1 * sn);
    }
    { const float* cw = INP(16); const float* cb = INP(17); bf16* X = WSP(bf16, WS_XBC);
      for (int idx = gt; idx < NTOK * 1024; idx += NT) { const int tok = idx >> 10, c = idx & 1023, s = tok & (SEQ - 1);
          float a = cb[c];
#pragma unroll
          for (int j = 0; j < 4; ++j) { const int ss = s - 3 + j; if (ss >= 0) a += cw[j * 1024 + c] * bf2f(P[(size_t)(tok - 3 + j) * HY_NP + C_XBC + c]); }
          X[idx] = (bf16)f2bf(siluf(a)); } }
    { const float* side = WSP(float, WS_SIDE); float* DT = WSP(float, WS_DT); const float* db = INP(18);
      for (int idx = gt; idx < NTOK * 8; idx += NT) { const int tok = idx >> 3, h = idx & 7; DT[idx] = softplusf(side[(size_t)tok * 32 + 24 + h] + db[h]); } }
}

__device__ __forceinline__ void phase_compress(const Ctx& C) {
    LAS float* X = (LAS float*)C.lds;
    LAS float* PE = X + 144 * 64;
    LAS float* HID = PE + 32 * 64;
    const bf16* P = WSP(bf16, WS_PROJ);
    for (int item = C.bid; item < 2 * NB * 2 * 64; item += C.G) {
        const int which = item & 1, g = (item >> 1) & 1, b = (item >> 2) & 3, nt = item >> 4;
        const float* pe = INP(8 + which); const float* w1 = INP(which ? 13 : 10); const float* b1 = INP(which ? 14 : 11); const float* w2 = INP(which ? 15 : 12);
        bf16* OUT = WSP(bf16, which ? WS_VC : WS_KC);
        const int col0 = C_KV + which * 128 + g * 64, t0 = nt * 128;
        for (int e = C.tid; e < 144 * 64; e += 512) { const int tt = e >> 6, d = e & 63, t = t0 + tt; X[e] = t < SEQ ? bf2f(P[(size_t)(b * SEQ + t) * HY_NP + col0 + d]) : 0.f; }
        for (int e = C.tid; e < 32 * 64; e += 512) PE[e] = pe[e];
        __syncthreads();
        const int nl = C.tid >> 6, c = C.tid & 63, n = nt * 8 + nl;
        float a = b1[c];
        for (int l = 0; l < 32; ++l) {
            const LAS float* xr = X + (16 * nl + l) * 64; const LAS float* pr = PE + l * 64; const float* wr = w1 + (size_t)(l * 64) * 64 + c;
#pragma unroll 8
            for (int d = 0; d < 64; ++d) a += (xr[d] + pr[d]) * wr[d * 64];
        }
        HID[nl * 64 + c] = siluf(a);
        __syncthreads();
        float o = 0.f;
#pragma unroll 8
        for (int j = 0; j < 64; ++j) o += HID[nl * 64 + j] * w2[j * 64 + c];
        OUT[((size_t)(b * 2 + g) * NCMP_P + n) * 64 + c] = (bf16)(n < NCMP ? f2bf(o) : 0u);
        __syncthreads();
    }
}

__device__ __forceinline__ void phase_ssd_s1(const Ctx& C) {
    LAS float* XW = (LAS float*)C.lds;
    LAS float* AV = XW + 256 * 64;
    LAS float* CS = AV + 256;
    const bf16* X = WSP(bf16, WS_XBC); const float* DT = WSP(float, WS_DT); float* ACS = WSP(float, WS_ACS); float* ST = WSP(float, WS_ST);
    for (int item = C.bid; item < NB * 32 * 8; item += C.G) {
        const int h = item & 7, c = (item >> 3) & 31, b = item >> 8, g = h >> 2;
        const size_t tok0 = (size_t)b * SEQ + c * 256;
        const float Ah = -__expf(INP(19)[h]);
        if (C.tid < 256) AV[C.tid] = DT[(tok0 + C.tid) * 8 + h] * Ah;
        __syncthreads();
        if (C.tid < 256) { float s = 0.f; for (int i = 0; i <= C.tid; ++i) s += AV[i]; CS[C.tid] = s; ACS[(tok0 + C.tid) * 8 + h] = s; }
        __syncthreads();
        const float last = CS[255];
        for (int e = C.tid; e < 256 * 64; e += 512) { const int l = e >> 6, p = e & 63;
            XW[e] = bf2f(X[(tok0 + l) * 1024 + h * 64 + p]) * DT[(tok0 + l) * 8 + h] * __expf(last - CS[l]); }
        __syncthreads();
        const int n = C.tid & 127, pg = C.tid >> 7;
        float acc[16];
#pragma unroll
        for (int i = 0; i < 16; ++i) acc[i] = 0.f;
        for (int l = 0; l < 256; ++l) { const float bv = bf2f(X[(tok0 + l) * 1024 + 512 + g * 128 + n]); const LAS float* xw = XW + l * 64 + pg * 16;
#pragma unroll
            for (int i = 0; i < 16; ++i) acc[i] += bv * xw[i]; }
        float* st = ST + (((size_t)(b * 32 + c) * 8 + h) * 64) * 128;
#pragma unroll
        for (int i = 0; i < 16; ++i) st[(pg * 16 + i) * 128 + n] = acc[i];
        __syncthreads();
    }
}
__device__ __forceinline__ void phase_ssd_s2(const Ctx& C) {
    float* ST = WSP(float, WS_ST); const float* ACS = WSP(float, WS_ACS);
    for (int idx = C.bid * 512 + C.tid; idx < NB * 8 * 64 * 128; idx += C.G * 512) {
        const int pn = idx & 8191, h = (idx >> 13) & 7, b = idx >> 16;
        float hs = 0.f;
        for (int c = 0; c < 32; ++c) { float* p = ST + (((size_t)(b * 32 + c) * 8 + h) * 8192) + pn; const float t = *p; *p = hs;
            hs = hs * __expf(ACS[((size_t)b * SEQ + c * 256 + 255) * 8 + h]) + t; }
    }
}
__device__ __forceinline__ void phase_ssd_s3(const Ctx& C) {
    LAS bf16* Bs = (LAS bf16*)C.lds;
    LAS float* CB = (LAS float*)(C.lds + 65536);
    LAS float* Y = CB + 32 * 256;
    LAS float* CS = Y + 32 * 256;
    LAS float* DTs = CS + 4 * 256;
    const bf16* X = WSP(bf16, WS_XBC); const bf16* P = WSP(bf16, WS_PROJ); const float* DT = WSP(float, WS_DT); const float* ACS = WSP(float, WS_ACS); const float* ST = WSP(float, WS_ST);
    bf16* MIXIN = WSP(bf16, WS_MIXIN);
    for (int item = C.bid; item < NB * 32 * 2; item += C.G) {
        const int g = item & 1, c = (item >> 1) & 31, b = item >> 6;
        const size_t tok0 = (size_t)b * SEQ + c * 256;
        for (int e = C.tid; e < 256 * 16; e += 512) { const int l = e >> 4, k = e & 15; *(LAS v4u*)(Bs + l * 128 + k * 8) = *(const v4u*)(X + (tok0 + l) * 1024 + 512 + g * 128 + k * 8); }
        for (int e = C.tid; e < 1024; e += 512) { const int hh = e >> 8, l = e & 255; CS[e] = ACS[(tok0 + l) * 8 + g * 4 + hh]; DTs[e] = DT[(tok0 + l) * 8 + g * 4 + hh]; }
        __syncthreads();
        for (int lt = 0; lt < 8; ++lt) {
            const int l0 = lt * 32;
            { const int li = C.tid >> 4, sg = C.tid & 15, l = l0 + li;
              float acc[16];
#pragma unroll
              for (int k = 0; k < 16; ++k) acc[k] = 0.f;
              const bf16* cr = X + (tok0 + l) * 1024 + 768 + g * 128;
              for (int n8 = 0; n8 < 16; ++n8) { const v4u cv = *(const v4u*)(cr + n8 * 8);
                  const float c0 = bflo(cv.x), c1 = bfhi(cv.x), c2 = bflo(cv.y), c3 = bfhi(cv.y), c4 = bflo(cv.z), c5 = bfhi(cv.z), c6 = bflo(cv.w), c7 = bfhi(cv.w);
#pragma unroll
                  for (int k = 0; k < 16; ++k) { const v4u bv = *(const LAS v4u*)(Bs + (sg + 16 * k) * 128 + n8 * 8);
                      acc[k] += c0 * bflo(bv.x) + c1 * bfhi(bv.x) + c2 * bflo(bv.y) + c3 * bfhi(bv.y) + c4 * bflo(bv.z) + c5 * bfhi(bv.z) + c6 * bflo(bv.w) + c7 * bfhi(bv.w); } }
#pragma unroll
              for (int k = 0; k < 16; ++k) { const int s = sg + 16 * k; CB[li * 256 + s] = (s <= l) ? acc[k] : 0.f; } }
            __syncthreads();
            { const int li = C.tid >> 4, hh = (C.tid >> 2) & 3, pq = C.tid & 3, l = l0 + li, h = g * 4 + hh, ch0 = h * 64 + pq * 16;
              float acc[16];
#pragma unroll
              for (int k = 0; k < 16; ++k) acc[k] = 0.f;
              const float al = CS[hh * 256 + l];
              for (int s = 0; s <= l; ++s) { const float w = CB[li * 256 + s] * __expf(al - CS[hh * 256 + s]) * DTs[hh * 256 + s];
                  const v4u x0 = *(const v4u*)(X + (tok0 + s) * 1024 + ch0), x1 = *(const v4u*)(X + (tok0 + s) * 1024 + ch0 + 8);
                  acc[0] += w * bflo(x0.x); acc[1] += w * bfhi(x0.x); acc[2] += w * bflo(x0.y); acc[3] += w * bfhi(x0.y); acc[4] += w * bflo(x0.z); acc[5] += w * bfhi(x0.z); acc[6] += w * bflo(x0.w); acc[7] += w * bfhi(x0.w);
                  acc[8] += w * bflo(x1.x); acc[9] += w * bfhi(x1.x); acc[10] += w * bflo(x1.y); acc[11] += w * bfhi(x1.y); acc[12] += w * bflo(x1.z); acc[13] += w * bfhi(x1.z); acc[14] += w * bflo(x1.w); acc[15] += w * bfhi(x1.w); }
              { const float* pv = ST + (((size_t)(b * 32 + c) * 8 + h) * 64 + pq * 16) * 128; const bf16* cr = X + (tok0 + l) * 1024 + 768 + g * 128; const float el = __expf(al);
                float off[16];
#pragma unroll
                for (int k = 0; k < 16; ++k) off[k] = 0.f;
                for (int n4 = 0; n4 < 32; ++n4) { const v2u cv = *(const v2u*)(cr + n4 * 4); const float c0 = bflo(cv.x), c1 = bfhi(cv.x), c2 = bflo(cv.y), c3 = bfhi(cv.y);
#pragma unroll
                    for (int k = 0; k < 16; ++k) { const f32x4 pp = *(const f32x4*)(pv + k * 128 + n4 * 4); off[k] += c0 * pp.x + c1 * pp.y + c2 * pp.z + c3 * pp.w; } }
#pragma unroll
                for (int k = 0; k < 16; ++k) acc[k] += el * off[k]; }
              { const float Dh = INP(20)[h]; const bf16* xr = X + (tok0 + l) * 1024 + ch0; const bf16* zr = P + (tok0 + l) * HY_NP + C_Z + ch0;
#pragma unroll
                for (int k = 0; k < 16; ++k) { const float y = acc[k] + Dh * bf2f(xr[k]); Y[li * 256 + hh * 64 + pq * 16 + k] = y * siluf(bf2f(zr[k])); } } }
            __syncthreads();
            { const float* ng = INP(21) + g * 256;
              for (int rr = C.wave; rr < 32; rr += 8) { const f32x4 v = *(const LAS f32x4*)(Y + rr * 256 + C.lane * 4);
                  const float ss = wave_sum(v.x * v.x + v.y * v.y + v.z * v.z + v.w * v.w); const float rs = 1.f / sqrtf(ss * (1.f / 256.f) + NORM_EPS);
                  const f32x4 gg = *(const f32x4*)(ng + C.lane * 4); v2u w; w.x = pk2(v.x * rs * gg.x, v.y * rs * gg.y); w.y = pk2(v.z * rs * gg.z, v.w * rs * gg.w);
                  *(v2u*)(MIXIN + (tok0 + l0 + rr) * 1024 + 512 + g * 256 + C.lane * 4) = w; } }
            __syncthreads();
        }
    }
}
typedef short bf16x8_t __attribute__((ext_vector_type(8)));
typedef short s16x4_t __attribute__((ext_vector_type(4)));
typedef float f32x2_t __attribute__((ext_vector_type(2)));
typedef __bf16 bf16x2_t __attribute__((ext_vector_type(2)));
__device__ __forceinline__ unsigned cvtpk(float lo, float hi) { f32x2_t v = {lo, hi}; bf16x2_t b = __builtin_convertvector(v, bf16x2_t); return __builtin_bit_cast(unsigned, b); }
__device__ __forceinline__ s16x4_t lds_tr16(const LAS unsigned char* p) { return __builtin_bit_cast(s16x4_t, __builtin_amdgcn_ds_read_tr16_b64_v4i16((LAS s16x4_t*)p)); }

constexpr int NSA_RS = 144;
constexpr int NSA_TILE = 64 * NSA_RS;
constexpr int NSA_BUF = 2 * NSA_TILE;
constexpr int NSA_IMPQ = 2 * NSA_BUF;
constexpr int NSA_IMPL = NSA_IMPQ + 32768;
constexpr int NSA_SELM = NSA_IMPL + 32768;
constexpr float NSA_C2 = 0.125f * 1.4426950408889634f;

template <int MODE>
__device__ __forceinline__ void nsa_pass(LAS unsigned char* lds, const bf16* Kg, const bf16* Vg, const size_t pitch, const int tile_lo, const int tile_hi,
                                         const bf16x8_t (&qf)[2][2], float (&m)[2], float (&l)[2], f32x4 (&O)[4][2], const float (&invl)[2],
                                         const int t_tok, const unsigned long long sel_lo, const unsigned long long sel_hi, LAS float* impq, LAS float* impl, int tid) {
    asm volatile("" : "+v"(tid));
    const int lane = tid & 63, c16 = lane & 15, g4 = lane >> 4;
    const int srow = tid >> 3, sch = tid & 7;
    const int ncv = t_tok >= 31 ? (t_tok - 15) >> 4 : 0;
    v4u kr, vr;
    { const size_t off = (size_t)(tile_lo * 64 + srow) * pitch + sch * 8; kr = *(const v4u*)(Kg + off); vr = *(const v4u*)(Vg + off); }
    { LAS unsigned char* b0 = lds + (tile_lo & 1) * NSA_BUF + srow * NSA_RS + sch * 16; *(LAS v4u*)b0 = kr; *(LAS v4u*)(b0 + NSA_TILE) = vr; }
    __syncthreads();
#pragma unroll 1
    for (int tile = tile_lo; tile <= tile_hi; ++tile) {
        const bool more = tile < tile_hi;
        if (more) { const size_t off = (size_t)((tile + 1) * 64 + srow) * pitch + sch * 8; kr = *(const v4u*)(Kg + off); vr = *(const v4u*)(Vg + off); }
        const LAS unsigned char* Kb = lds + (tile & 1) * NSA_BUF; const LAS unsigned char* Vb = Kb + NSA_TILE;
        bool act = true;
        if (MODE == 2) { const unsigned long long wsel = (tile & 64) ? sel_hi : sel_lo; act = ((wsel >> (tile & 63)) & 1ull) != 0ull; }
        if (MODE != 2 || __any(act)) {
            f32x4 s[4][2];
#pragma unroll
            for (int rt = 0; rt < 4; ++rt) {
                const bf16x8_t k0 = *(const LAS bf16x8_t*)(Kb + (16 * rt + c16) * NSA_RS + 16 * g4), k1 = *(const LAS bf16x8_t*)(Kb + (16 * rt + c16) * NSA_RS + 64 + 16 * g4);
#pragma unroll
                for (int ct = 0; ct < 2; ++ct) { f32x4 a = {0.f, 0.f, 0.f, 0.f}; a = __builtin_amdgcn_mfma_f32_16x16x32_bf16(k0, qf[ct][0], a, 0, 0, 0); s[rt][ct] = __builtin_amdgcn_mfma_f32_16x16x32_bf16(k1, qf[ct][1], a, 0, 0, 0); }
            }
#pragma unroll
            for (int rt = 0; rt < 4; ++rt)
#pragma unroll
                for (int r = 0; r < 4; ++r) { const int key = tile * 64 + 16 * rt + 4 * g4 + r; bool ok;
                    if (MODE <= 1) ok = key < ncv; else if (MODE == 2) ok = act && key <= t_tok; else ok = key <= t_tok && key >= t_tok - 511;
#pragma unroll
                    for (int ct = 0; ct < 2; ++ct) s[rt][ct][r] = ok ? s[rt][ct][r] * NSA_C2 : -INFINITY; }
            if (MODE != 1) {
#pragma unroll
                for (int ct = 0; ct < 2; ++ct) {
                    float mx = fmaxf(fmaxf(s[0][ct][0], s[0][ct][1]), fmaxf(s[0][ct][2], s[0][ct][3]));
#pragma unroll
                    for (int rt = 1; rt < 4; ++rt) mx = fmaxf(mx, fmaxf(fmaxf(s[rt][ct][0], s[rt][ct][1]), fmaxf(s[rt][ct][2], s[rt][ct][3])));
                    mx = x32_max(x16_max(mx));
                    const float mn = fmaxf(m[ct], mx), corr = __builtin_amdgcn_exp2f(m[ct] - mn); m[ct] = mn;
                    float ps = 0.f;
#pragma unroll
                    for (int rt = 0; rt < 4; ++rt)
#pragma unroll
                        for (int r = 0; r < 4; ++r) { const float p = __builtin_amdgcn_exp2f(s[rt][ct][r] - mn); s[rt][ct][r] = p; ps += p; }
                    l[ct] = l[ct] * corr + ps;
                    if (MODE != 0) {
#pragma unroll
                        for (int dt = 0; dt < 4; ++dt) O[dt][ct] *= corr; }
                }
            } else {
#pragma unroll
                for (int ct = 0; ct < 2; ++ct)
#pragma unroll
                    for (int rt = 0; rt < 4; ++rt)
#pragma unroll
                        for (int r = 0; r < 4; ++r) s[rt][ct][r] = __builtin_amdgcn_exp2f(s[rt][ct][r] - m[ct]) * invl[ct];
#pragma unroll
                for (int rt = 0; rt < 4; ++rt) {
                    float q4 = ((s[rt][0][0] + s[rt][0][1]) + (s[rt][0][2] + s[rt][0][3])) + ((s[rt][1][0] + s[rt][1][1]) + (s[rt][1][2] + s[rt][1][3]));
                    float l3 = s[rt][0][3] + s[rt][1][3];
                    q4 += dppf<DPP_ROR8>(q4); l3 += dppf<DPP_ROR8>(l3);
                    if (c16 < 8) { const int j0 = tile * 16 + 4 * rt + g4; impq[c16 * 128 + j0] = q4; impl[c16 * 128 + j0] = l3; }
                }
            }
            if (MODE != 0) {
#pragma unroll
                for (int ks = 0; ks < 2; ++ks) {
                    bf16x8_t pf[2];
#pragma unroll
                    for (int ct = 0; ct < 2; ++ct) { v4u w; w.x = cvtpk(s[2 * ks][ct][0], s[2 * ks][ct][1]); w.y = cvtpk(s[2 * ks][ct][2], s[2 * ks][ct][3]);
                        w.z = cvtpk(s[2 * ks + 1][ct][0], s[2 * ks + 1][ct][1]); w.w = cvtpk(s[2 * ks + 1][ct][2], s[2 * ks + 1][ct][3]); pf[ct] = __builtin_bit_cast(bf16x8_t, w); }
#pragma unroll
                    for (int dt = 0; dt < 4; ++dt) {
                        const LAS unsigned char* va = Vb + (32 * ks + 4 * g4 + (c16 >> 2)) * NSA_RS + (16 * dt + 4 * (c16 & 3)) * 2;
                        const s16x4_t lo = lds_tr16(va), hi = lds_tr16(va + 16 * NSA_RS);
                        const bf16x8_t vf = {lo[0], lo[1], lo[2], lo[3], hi[0], hi[1], hi[2], hi[3]};
#pragma unroll
                        for (int ct = 0; ct < 2; ++ct) O[dt][ct] = __builtin_amdgcn_mfma_f32_16x16x32_bf16(vf, pf[ct], O[dt][ct], 0, 0, 0);
                    }
                }
            }
        }
        if (more) { LAS unsigned char* b1 = lds + ((tile + 1) & 1) * NSA_BUF + srow * NSA_RS + sch * 16; *(LAS v4u*)b1 = kr; *(LAS v4u*)(b1 + NSA_TILE) = vr; }
        __syncthreads();
    }
}

__device__ __forceinline__ void phase_nsa(const Ctx& C) {
    const bf16* P = WSP(bf16, WS_PROJ); const bf16* KC = WSP(bf16, WS_KC); const bf16* VC = WSP(bf16, WS_VC); const float* side = WSP(float, WS_SIDE);
    bf16* MIXIN = WSP(bf16, WS_MIXIN);
#pragma unroll 1
    for (int idx = C.bid; idx < 1024; idx += C.G) {
        int tid = C.tid; asm volatile("" : "+v"(tid));
        const int lane = tid & 63, w = __builtin_amdgcn_readfirstlane(tid >> 6), c16 = lane & 15, g4 = lane >> 4;
        LAS float* impq = (LAS float*)(C.lds + NSA_IMPQ) + w * 1024; LAS float* impl = (LAS float*)(C.lds + NSA_IMPL) + w * 1024;
        LAS unsigned* selw = (LAS unsigned*)(C.lds + NSA_SELM) + w * 64;
        const int k4 = idx >> 8, bg = (idx & 255) >> 5, sx = idx & 31, b = bg >> 1, g = bg & 1;
        const int qt = k4 == 0 ? sx : (k4 == 1 ? 63 - sx : (k4 == 2 ? 64 + sx : 127 - sx));
        const int t0 = qt * 64, tl = t0 + 8 * w + (c16 & 7);
        const size_t tok = (size_t)b * SEQ + tl;
        const bf16* Pb = P + (size_t)b * SEQ * HY_NP;
        bf16x8_t qf[2][2];
#pragma unroll
        for (int ct = 0; ct < 2; ++ct)
#pragma unroll
            for (int ds = 0; ds < 2; ++ds) qf[ct][ds] = *(const bf16x8_t*)(P + tok * HY_NP + (g * 4 + 2 * ct + (c16 >> 3)) * 64 + 32 * ds + 8 * g4);
        float gate[2][3];
#pragma unroll
        for (int ct = 0; ct < 2; ++ct)
#pragma unroll
            for (int i = 0; i < 3; ++i) gate[ct][i] = sigmf(side[tok * 32 + (g * 4 + 2 * ct + (c16 >> 3)) * 3 + i]);
        for (int e = lane; e < 1024; e += 64) { impq[e] = 0.f; impl[e] = 0.f; }
        f32x4 OT[4][2], O[4][2];
#pragma unroll
        for (int dt = 0; dt < 4; ++dt)
#pragma unroll
            for (int ct = 0; ct < 2; ++ct) { OT[dt][ct] = (f32x4){0.f, 0.f, 0.f, 0.f}; O[dt][ct] = (f32x4){0.f, 0.f, 0.f, 0.f}; }
        float m[2], l[2], invl[2]; unsigned long long sel_lo = 0ull, sel_hi = 0ull;
        { const bf16* Kc = KC + (size_t)bg * NCMP_P * 64; const bf16* Vc = VC + (size_t)bg * NCMP_P * 64;
          const int nct = (4 * qt + 3 + 63) >> 6;
          m[0] = m[1] = -1e30f; l[0] = l[1] = 0.f; invl[0] = invl[1] = 0.f;
          nsa_pass<0>(C.lds, Kc, Vc, 64, 0, nct - 1, qf, m, l, O, invl, tl, sel_lo, sel_hi, impq, impl, tid);
#pragma unroll
          for (int ct = 0; ct < 2; ++ct) { float lt = x32_sum(x16_sum(l[ct])); invl[ct] = lt > 0.f ? 1.f / lt : 0.f; }
          nsa_pass<1>(C.lds, Kc, Vc, 64, 0, nct - 1, qf, m, l, O, invl, tl, sel_lo, sel_hi, impq, impl, tid);
#pragma unroll
          for (int dt = 0; dt < 4; ++dt)
#pragma unroll
              for (int ct = 0; ct < 2; ++ct) { OT[dt][ct] += O[dt][ct] * gate[ct][0]; O[dt][ct] = (f32x4){0.f, 0.f, 0.f, 0.f}; } }
        { LDS_WAIT();
          const int tk = lane >> 3, sub = lane & 7;
          unsigned key[16]; unsigned bits = 0u;
#pragma unroll
          for (int e = 0; e < 16; ++e) { const int j = 16 * sub + e; float v = impq[tk * 128 + j]; if (j > 0) v += impl[tk * 128 + j - 1];
              const bool forced = (j == 0) | (j == qt) | (j == qt - 1), valid = j <= qt;
              if (forced) bits |= 1u << e;
              key[e] = (valid && !forced) ? (((__builtin_bit_cast(unsigned, v) & ~127u) | (unsigned)(127 - j)) + 1u) : 0u; }
          const int nsel = 16 - (qt >= 2 ? 3 : qt + 1);
#pragma unroll 1
          for (int r = 0; r < nsel; ++r) {
              unsigned mx = key[0];
#pragma unroll
              for (int e = 1; e < 16; ++e) mx = key[e] > mx ? key[e] : mx;
              { unsigned o = dppu<DPP_XOR1>(mx); mx = o > mx ? o : mx; o = dppu<DPP_XOR2>(mx); mx = o > mx ? o : mx; o = dppu<0x141>(mx); mx = o > mx ? o : mx; }
              if (mx != 0u) {
#pragma unroll
                  for (int e = 0; e < 16; ++e) if (key[e] == mx) { key[e] = 0u; bits |= 1u << e; } }
          }
          selw[tk * 8 + sub] = bits;
          LDS_WAIT();
          const int mt = c16 & 7;
          sel_lo = (unsigned long long)((selw[mt * 8 + 0] & 0xffffu) | (selw[mt * 8 + 1] << 16)) | ((unsigned long long)((selw[mt * 8 + 2] & 0xffffu) | (selw[mt * 8 + 3] << 16)) << 32);
          sel_hi = (unsigned long long)((selw[mt * 8 + 4] & 0xffffu) | (selw[mt * 8 + 5] << 16)) | ((unsigned long long)((selw[mt * 8 + 6] & 0xffffu) | (selw[mt * 8 + 7] << 16)) << 32);
        }
        m[0] = m[1] = -1e30f; l[0] = l[1] = 0.f;
        nsa_pass<2>(C.lds, Pb + C_KV + 2 * 128 + g * 64, Pb + C_KV + 3 * 128 + g * 64, HY_NP, 0, qt, qf, m, l, O, invl, tl, sel_lo, sel_hi, impq, impl, tid);
#pragma unroll
        for (int ct = 0; ct < 2; ++ct) { float lt = x32_sum(x16_sum(l[ct])); const float sc = gate[ct][1] / lt;
#pragma unroll
            for (int dt = 0; dt < 4; ++dt) { OT[dt][ct] += O[dt][ct] * sc; O[dt][ct] = (f32x4){0.f, 0.f, 0.f, 0.f}; } }
        m[0] = m[1] = -1e30f; l[0] = l[1] = 0.f;
        nsa_pass<3>(C.lds, Pb + C_KV + 4 * 128 + g * 64, Pb + C_KV + 5 * 128 + g * 64, HY_NP, qt >= 8 ? qt - 8 : 0, qt, qf, m, l, O, invl, tl, sel_lo, sel_hi, impq, impl, tid);
#pragma unroll
        for (int ct = 0; ct < 2; ++ct) { float lt = x32_sum(x16_sum(l[ct])); const float sc = gate[ct][2] / lt;
#pragma unroll
            for (int dt = 0; dt < 4; ++dt) OT[dt][ct] += O[dt][ct] * sc; }
#pragma unroll
        for (int ct = 0; ct < 2; ++ct)
#pragma unroll
            for (int dt = 0; dt < 4; ++dt) { v2u wv; wv.x = cvtpk(OT[dt][ct][0], OT[dt][ct][1]); wv.y = cvtpk(OT[dt][ct][2], OT[dt][ct][3]);
                *(v2u*)(MIXIN + tok * 1024 + (g * 4 + 2 * ct + (c16 >> 3)) * 64 + 16 * dt + 4 * g4) = wv; }
    }
}
__device__ __forceinline__ void phase_ffn_act(const Ctx& C, int layer) {
    const bf16* U = WSP(bf16, WS_U); bf16* ACT = WSP(bf16, WS_ACT);
    const float* cw = INP(29) + (size_t)layer * 3 * FF2; const float* cb = INP(30) + (size_t)layer * FF2;
    for (int idx = C.bid * 512 + C.tid; idx < SEQ * (FF / 2); idx += C.G * 512) {
        const int t = idx / (FF / 2), c = (idx - t * (FF / 2)) * 2;
        float g0 = cb[c], g1 = cb[c + 1], v0 = cb[FF + c], v1 = cb[FF + c + 1];
#pragma unroll
        for (int j = 0; j < 3; ++j) { const int tt = t - 2 + j; if (tt >= 0) { const unsigned ug = *(const unsigned*)(U + (size_t)tt * FF2 + c), uv = *(const unsigned*)(U + (size_t)tt * FF2 + FF + c);
            g0 += cw[j * FF2 + c] * bflo(ug); g1 += cw[j * FF2 + c + 1] * bfhi(ug); v0 += cw[j * FF2 + FF + c] * bflo(uv); v1 += cw[j * FF2 + FF + c + 1] * bfhi(uv); } }
        *(unsigned*)(ACT + (size_t)t * FF + c) = pk2(siluf(g0) * v0, siluf(g1) * v1);
    }
}

__device__ __forceinline__ void phase_gdn_prep(const Ctx& C) {
    const bf16* QKV = WSP(bf16, WS_QKV); const float* cw = INP(23);
    bf16* QN = WSP(bf16, WS_QN); bf16* KN = WSP(bf16, WS_KN); bf16* VN = WSP(bf16, WS_VN);
    const int gw = C.bid * 8 + C.wave, NGW = C.G * 8, lane = C.lane;
    for (int item = gw; item < NTOK * 24; item += NGW) {
        const int tok = item / 24, rem = item - tok * 24, which = rem >> 3, h = rem & 7, s = tok & (SEQ - 1);
        const int col = which * 1024 + h * 128 + lane * 2;
        float a0 = 0.f, a1 = 0.f;
#pragma unroll
        for (int j = 0; j < 4; ++j) { const int ss = s - 3 + j; if (ss >= 0) { const unsigned u = *(const unsigned*)(QKV + (size_t)(tok - 3 + j) * 3072 + col); a0 += cw[j * 3072 + col] * bflo(u); a1 += cw[j * 3072 + col + 1] * bfhi(u); } }
        a0 = siluf(a0); a1 = siluf(a1);
        if (which < 2) { const float ss = wave_sum(a0 * a0 + a1 * a1); float rs = 1.f / sqrtf(ss + NORM_EPS); if (which == 0) rs *= 0.08838834764831845f; a0 *= rs; a1 *= rs; }
        bf16* dst = which == 0 ? QN : (which == 1 ? KN : VN);
        *(unsigned*)(dst + (size_t)tok * 1024 + h * 128 + lane * 2) = pk2(a0, a1);
    }
    { const float* side = WSP(float, WS_SIDE2); float* BETA = WSP(float, WS_BETA); float* GG = WSP(float, WS_G); const float* db = INP(24); const float* al = INP(25);
      for (int idx = C.bid * 512 + C.tid; idx < NTOK * 8; idx += C.G * 512) { const int tok = idx >> 3, h = idx & 7;
          BETA[idx] = sigmf(side[(size_t)tok * 16 + h]); GG[idx] = -__expf(al[h]) * softplusf(side[(size_t)tok * 16 + 8 + h] + db[h]); } }
}
__device__ __forceinline__ void phase_gdn_rec(const Ctx& C) {
    const bf16* QN = WSP(bf16, WS_QN); const bf16* KN = WSP(bf16, WS_KN); const bf16* VN = WSP(bf16, WS_VN); const float* BETA = WSP(float, WS_BETA); const float* GG = WSP(float, WS_G);
    float* O = WSP(float, WS_O1);
    const int gw = C.bid * 8 + C.wave, NGW = C.G * 8, lane = C.lane;
    for (int item = gw; item < NB * 8 * 64; item += NGW) {
        const int ep = item & 63, h = (item >> 6) & 7, b = item >> 9, e0 = ep * 2;
        float s00 = 0.f, s01 = 0.f, s10 = 0.f, s11 = 0.f;
        const size_t base = (size_t)b * SEQ;
        for (int t = 0; t < SEQ; ++t) {
            const size_t tok = base + t;
            const unsigned ku = *(const unsigned*)(KN + tok * 1024 + h * 128 + lane * 2), qu = *(const unsigned*)(QN + tok * 1024 + h * 128 + lane * 2);
            const unsigned vu = *(const unsigned*)(VN + tok * 1024 + h * 128 + e0);
            const float k0 = bflo(ku), k1 = bfhi(ku), q0 = bflo(qu), q1 = bfhi(qu), v0 = bflo(vu), v1 = bfhi(vu);
            const float eg = __expf(GG[tok * 8 + h]), be = BETA[tok * 8 + h];
            s00 *= eg; s01 *= eg; s10 *= eg; s11 *= eg;
            const float kv0 = wave_sum(k0 * s00 + k1 * s01), kv1 = wave_sum(k0 * s10 + k1 * s11);
            const float d0 = be * (v0 - kv0), d1 = be * (v1 - kv1);
            s00 += k0 * d0; s01 += k1 * d0; s10 += k0 * d1; s11 += k1 * d1;
            const float o0 = wave_sum(q0 * s00 + q1 * s01), o1 = wave_sum(q0 * s10 + q1 * s11);
            if (lane == 0) { O[tok * 1024 + h * 128 + e0] = o0; O[tok * 1024 + h * 128 + e0 + 1] = o1; }
        }
    }
}
__device__ __forceinline__ void phase_gdn_gate(const Ctx& C) {
    const float* O = WSP(float, WS_O1); const bf16* Z = WSP(bf16, WS_Z1); bf16* GIN = WSP(bf16, WS_GIN); const float* ng = INP(26);
    const int gw = C.bid * 8 + C.wave, NGW = C.G * 8, lane = C.lane;
    for (int item = gw; item < NTOK * 8; item += NGW) {
        const size_t off = (size_t)item * 128 + lane * 2;
        const float o0 = O[off], o1 = O[off + 1];
        const float rs = 1.f / sqrtf(wave_sum(o0 * o0 + o1 * o1) * (1.f / 128.f) + NORM_EPS);
        const unsigned zu = *(const unsigned*)(Z + off);
        *(unsigned*)(GIN + off) = pk2(o0 * rs * ng[lane * 2] * siluf(bflo(zu)), o1 * rs * ng[lane * 2 + 1] * siluf(bfhi(zu)));
    }
}

constexpr int N_PHASES = 47;
#ifndef PHMASK
#define PHMASK 0xFFFFFFFFFFFFFFFFull
#endif
#define EN(k) (((PHMASK) >> (k)) & 1ull)
#ifndef REP_PH
#define REP_PH (-1)
#endif

__global__ void __launch_bounds__(512, 2) mega_fwd(Args args) {
    extern __shared__ __attribute__((aligned(16))) unsigned char lds_raw[];
    XcdBarrier bar;
    Ctx C0;
    C0.lds = (LAS unsigned char*)lds_raw;
    C0.tid = threadIdx.x; C0.lane = C0.tid & 63; C0.wave = __builtin_amdgcn_readfirstlane(C0.tid >> 6); C0.G = gridDim.x; C0.bid = blockIdx.x;
    { const Ctx& C = C0;
    volatile LAS unsigned* MISC = (volatile LAS unsigned*)(C.lds + MISC_OFF);
    if (C.tid < 16) MISC[C.tid] = 0u;
    if (C.tid == 0) { LAS unsigned long long* pt = (LAS unsigned long long*)(C.lds + PTR_OFF);
#pragma unroll
        for (int i = 0; i < 32; ++i) pt[i] = (unsigned long long)args.in[i];
        pt[32] = (unsigned long long)args.out; pt[33] = (unsigned long long)args.ws;
        LAS float* fq = (LAS float*)(C.lds + PTR_OFF + 34 * 8);
#pragma unroll
        for (int i = 0; i < 8; ++i) fq[i] = args.ifq.f[i]; }
    __syncthreads();
    gu32* ctl = (gu32*)(ldptr(C, 33) + WS_CTL);
    bar.bar = (unsigned*)(ctl + CW_BAR); bar.x = 0; bar.st = nullptr;
    const bool multi = (args.ph_hi - args.ph_lo) > 1;
    if (multi) bar = xcd_barrier_post((unsigned*)(ctl + CW_BAR), MISC + 8);
    if (multi) { cooperative_groups::this_grid().sync(); }
    }

    const int ph_lo = args.ph_lo, ph_hi = args.ph_hi;
#define MKCTX Ctx C; { int tid = threadIdx.x, bid = blockIdx.x, G = gridDim.x; asm volatile("" : "+v"(tid)); asm volatile("" : "+s"(bid)); asm volatile("" : "+s"(G)); \
                 C.lds = (LAS unsigned char*)lds_raw; C.tid = tid; C.lane = tid & 63; C.wave = __builtin_amdgcn_readfirstlane(tid >> 6); C.G = G; C.bid = bid; }
#define PH(k, BODY) if (EN(k) && ph_lo <= (k) && (k) < ph_hi) { { MKCTX BODY } if (REP_PH == (k)) { xcd_barrier(bar); { MKCTX BODY } } if ((k) + 1 < ph_hi) xcd_barrier(bar); }
#define GEMM_CALL(EPI, A_, B_, M_, N_, K_, EINIT) { pg8::Gemm g{A_, B_, M_, N_, K_}; pg8::StaticOrder S; S.init(M_, N_, C.G, C.bid); EPI E EINIT; pg8::gemm_phase<EPI, pg8::StaticOrder, true, true>(C.lds, g, S, E, C.tid); }
    PH(0, phase_prologue(C);)
    PH(1, GEMM_CALL(EpiHyIn, WSP(bf16, WS_HN), WSP(bf16, WS_W_HYIN), NTOK, HY_NP, DM, ({WSP(bf16, WS_PROJ), WSP(float, WS_SIDE)})))
    PH(2, phase_rope_conv(C);)
    PH(3, phase_compress(C); phase_ssd_s1(C);)
    PH(4, phase_ssd_s2(C);)
    PH(5, phase_ssd_s3(C);)
    PH(6, phase_nsa(C);)
    PH(7, GEMM_CALL(EpiF32, WSP(bf16, WS_MIXIN), WSP(bf16, WS_W_HYOUT), NTOK, DM, DM, ({WSP(float, WS_MIX), DM})))
    PH(8, phase_res(C, INP(0), OUTP(), WSP(float, WS_MIX), 0, NTOK, INP(3), INP(4), WSP(bf16, WS_HN));)
#pragma unroll 1
    for (int ph = 9; ph < 47; ++ph) {
        if (ph == 25) {
            PH(25, GEMM_CALL(EpiGdnIn, WSP(bf16, WS_HN), WSP(bf16, WS_W_GDNIN), NTOK, GDN_NP, DM, ({WSP(bf16, WS_QKV), WSP(bf16, WS_Z1), WSP(float, WS_SIDE2)})))
            PH(26, phase_gdn_prep(C);)
            PH(27, phase_gdn_rec(C);)
            PH(28, phase_gdn_gate(C);)
            PH(29, GEMM_CALL(EpiF32, WSP(bf16, WS_GIN), WSP(bf16, WS_W_GDNOUT), NTOK, DM, DM, ({WSP(float, WS_MIX1), DM})))
            PH(30, phase_res(C, OUTP(), OUTP(), WSP(float, WS_MIX1), 0, NTOK, INP(3) + DM, INP(4) + DM, WSP(bf16, WS_HN));)
            ph = 30; continue;
        }
        if (EN(9) && ph_lo <= ph && ph < ph_hi) {
            { MKCTX
              const int layer = ph >= 31 ? 1 : 0, k = ph - (layer ? 31 : 9), b = k >> 2, step = k & 3;
              if (step == 0) GEMM_CALL(EpiB16, WSP(bf16, WS_HN) + (size_t)b * SEQ * DM, (layer ? WSP(bf16, WS_W_UP1) : WSP(bf16, WS_W_UP0)), SEQ, FF2, DM, ({WSP(bf16, WS_U), FF2}))
              else if (step == 1) phase_ffn_act(C, layer);
              else if (step == 2) GEMM_CALL(EpiF32, WSP(bf16, WS_ACT), (layer ? WSP(bf16, WS_W_DN1) : WSP(bf16, WS_W_DN0)), SEQ, DM, FF, ({WSP(float, WS_F), DM}))
              else phase_res(C, OUTP(), OUTP(), WSP(float, WS_F), b * SEQ, SEQ, INP(5) + layer * DM, layer ? (const float*)nullptr : INP(2) + DM, WSP(bf16, WS_HN));
            }
            if (ph + 1 < ph_hi) xcd_barrier(bar);
        }
    }
}

extern "C" void kernel_launch(void* const* d_in, const int* in_sizes, int n_in, void* d_out, int out_size, void* d_ws, size_t ws_size, hipStream_t stream) {
    static int grid = 0;
    if (grid == 0) {
        if (n_in != 32 || in_sizes[0] != NTOK * DM || out_size != NTOK * DM || ws_size < WS_END) {
            fprintf(stderr, "kernel_launch: unexpected shapes: n_in %d in0 %d out %d ws %zu (need %zu); nothing launched\n", n_in, n_in > 0 ? in_sizes[0] : -1, out_size, ws_size, (size_t)WS_END); grid = -1; return; }
        int dev = 0, cus = 0, per_cu = 0;
        if (hipGetDevice(&dev) != hipSuccess || hipDeviceGetAttribute(&cus, hipDeviceAttributeMultiprocessorCount, dev) != hipSuccess) { grid = -1; return; }
        if (hipFuncSetAttribute((const void*)mega_fwd, hipFuncAttributeMaxDynamicSharedMemorySize, LDS_BYTES) != hipSuccess) { fprintf(stderr, "kernel_launch: hipFuncSetAttribute failed\n"); grid = -1; return; }
        if (hipOccupancyMaxActiveBlocksPerMultiprocessor(&per_cu, (const void*)mega_fwd, 512, LDS_BYTES) != hipSuccess || per_cu < 1) { fprintf(stderr, "kernel_launch: occupancy query says %d blocks per CU\n", per_cu); (void)hipGetLastError(); grid = -1; return; }
        grid = cus;
    }
    if (grid < 0) return;
    if (hipMemsetAsync((char*)d_ws + WS_CTL, 0, CTL_ZERO_BYTES, stream) != hipSuccess) { fprintf(stderr, "kernel_launch: memset failed\n"); return; }
    Args a{};
    for (int i = 0; i < 32; ++i) a.in[i] = (const float*)d_in[i];
    a.out = (float*)d_out; a.ws = (unsigned char*)d_ws;
    for (int i = 0; i < 8; ++i) a.ifq.f[i] = (float)pow(500000.0, -(double)(2 * i) / 16.0);
#if MK_ONE_LAUNCH
    a.ph_lo = 0; a.ph_hi = N_PHASES;
    void* kargs[] = {&a};
    hipError_t e = hipLaunchCooperativeKernel((const void*)mega_fwd, dim3(grid), dim3(512), kargs, LDS_BYTES, stream);
    if (e != hipSuccess) fprintf(stderr, "kernel_launch: cooperative launch failed: %s (grid %d)\n", hipGetErrorString(e), grid);
#else
    for (int ph = 0; ph < N_PHASES; ++ph) { a.ph_lo = ph; a.ph_hi = ph + 1; hipLaunchKernelGGL(mega_fwd, dim3(grid), dim3(512), LDS_BYTES, stream, a); }
#endif
}
```

```cpp
#include <hip/hip_runtime.h>
#include <hip/hip_cooperative_groups.h>
#include <cstdio>
#include <cstdint>
#ifndef MK_ONE_LAUNCH
#define MK_ONE_LAUNCH 1
#endif
namespace pg8 {
#define PG8_LAS __attribute__((address_space(3)))
typedef unsigned short bf16_t;
typedef short bf16x8 __attribute__((ext_vector_type(8)));
typedef float f32x4 __attribute__((ext_vector_type(4)));
typedef unsigned u32x4 __attribute__((ext_vector_type(4)));
constexpr int BM = 256, BK = 64, HALF = 128, HTB = HALF * BK * 2  , STAGE_BYTES = 8 * HTB, NXCD = 8, WGM = 8;

__host__ __device__ __forceinline__ int lds_byte(int r, int c) { const int st = (r >> 4) * 2 + (c >> 5), rr = r & 15, cc = c & 31, ob = rr * 64 + cc * 2; return st * 1024 + (ob ^ (((ob >> 9) & 1) << 5)); }
__host__ __device__ __forceinline__ void stage_rc(int b, int& R, int& C) { const int st = b / 1024, sb = b % 1024, swz = sb ^ (((sb >> 9) & 1) << 5); R = (st >> 1) * 16 + swz / 64; C = (st & 1) * 32 + (swz % 64) / 2; }
__host__ __device__ __forceinline__ int perm32(int rho) { const int n = rho >> 4, i = rho & 15; return 8 * (i >> 2) + 4 * n + (i & 3); }

struct Unit { int pm, pn; };
struct Gemm { const bf16_t* A; const bf16_t* Bt; int M, N, K; };

struct StaticOrder {
    int nM, nN, nwg, G, c;
    __host__ __device__ void init(int M, int N, int G_, int c_) { nM = M / BM; nN = N / BM; nwg = nM * nN; G = G_; c = c_; }
    __host__ __device__ bool next(int i, Unit& u) const {
        const long L = (long)i * G + c; if (L >= nwg) return false;
        int wgid = (int)L; { const int q = nwg / NXCD, r = nwg % NXCD, xcd = wgid % NXCD, off = wgid / NXCD; wgid = (xcd < r ? xcd * (q + 1) : r * (q + 1) + (xcd - r) * q) + off; }
        const int nig = WGM * nN, gid = wgid / nig, fm = gid * WGM, gsz = (nM - fm) < WGM ? (nM - fm) : WGM;
        u.pm = fm + ((wgid % nig) % gsz); u.pn = (wgid % nig) / gsz; return true;
    }
    __device__ __forceinline__ void a_ready(const Unit&) const {}
    __device__ __forceinline__ void done(const Unit&) const {}
};

__device__ __forceinline__ unsigned cvt_pk_bf16(float lo, float hi) { unsigned r; asm volatile("v_cvt_pk_bf16_f32 %0, %1, %2" : "=v"(r) : "v"(lo), "v"(hi)); return r; }

template <class Epi, class Sched, bool ALIGN_EPI = false, bool SP2 = false>
__device__ __forceinline__ void gemm_phase(PG8_LAS unsigned char* lds, const Gemm g, const Sched& S, const Epi& E, const int tid) {
    const int  wid = __builtin_amdgcn_readfirstlane(tid >> 6), lane = tid & 63, wr = wid >> 2, wc = wid & 3, fr = lane & 15, fq = lane >> 4;
    const int K = g.K, nt = K / BK;
    unsigned voffA[2], voffB[2];
#pragma unroll
    for (int i = 0; i < 2; ++i) { int R, C; stage_rc(tid * 16 + i * 8192, R, C); const int Rb = Epi::PERM ? ((R & ~31) + perm32(R & 31)) : R;
        voffA[i] = (unsigned)(R * K + C) * 2u; voffB[i] = (unsigned)(Rb * K + C) * 2u; }
    const size_t kstep = (size_t)(BK * 2);
    const size_t hstep = (size_t)HALF * K * 2;
    const size_t tstep = 2 * hstep;
    const unsigned ldsw = (unsigned)wid * 1024u;
    const int aoff = lds_byte(wr * 64 + fr, fq * 8), boff = lds_byte(wc * 32 + fr, fq * 8);
#define PG8_SA(b, h) (((b) * 2 + (h)) * HTB)
#define PG8_SB(b, h) ((4 + (b) * 2 + (h)) * HTB)
#define PG8_STAGE(bufoff, gbase, voff) do { _Pragma("unroll") for (int _i = 0; _i < 2; ++_i) \
        __builtin_amdgcn_global_load_lds((const unsigned*)((const char*)(gbase) + (voff)[_i]), (PG8_LAS unsigned*)(lds + (bufoff) + ldsw + _i * 8192), 16, 0, 0); } while (0)
#define PG8_LDA(dst, b, h) do { _Pragma("unroll") for (int m = 0; m < 4; ++m) _Pragma("unroll") for (int k = 0; k < 2; ++k) dst[m][k] = *(const PG8_LAS bf16x8*)(lds + PG8_SA(b, h) + aoff + m * 2048 + k * 1024); } while (0)
#define PG8_LDB(dst, b, h) do { _Pragma("unroll") for (int n = 0; n < 2; ++n) _Pragma("unroll") for (int k = 0; k < 2; ++k) dst[n][k] = *(const PG8_LAS bf16x8*)(lds + PG8_SB(b, h) + boff + n * 2048 + k * 1024); } while (0)
#define PG8_MMA(ai, bj, At, Bt) do { __builtin_amdgcn_s_setprio(1); _Pragma("unroll") for (int m = 0; m < 4; ++m) _Pragma("unroll") for (int n = 0; n < 2; ++n) _Pragma("unroll") for (int k = 0; k < 2; ++k) \
        acc[ai][bj][m][n] = __builtin_amdgcn_mfma_f32_16x16x32_bf16(Bt[n][k], At[m][k], acc[ai][bj][m][n], 0, 0, 0); __builtin_amdgcn_s_setprio(0); } while (0)
#define PG8_WAIT_V(n) asm volatile("s_waitcnt vmcnt(" #n ")" ::: "memory")
#define PG8_WAIT_L(n) asm volatile("s_waitcnt lgkmcnt(" #n ")" ::: "memory")
#define PG8_BAR __builtin_amdgcn_s_barrier()
#define PG8_SCHED __builtin_amdgcn_sched_barrier(0)
    Unit cur, nxt; int ui = 0;
    if (!S.next(0, cur)) return;
    f32x4 acc[2][2][4][2];
#pragma unroll
    for (int a = 0; a < 2; ++a)
#pragma unroll
        for (int b = 0; b < 2; ++b)
#pragma unroll
            for (int m = 0; m < 4; ++m)
#pragma unroll
                for (int n = 0; n < 2; ++n) acc[a][b][m][n] = (f32x4){0.f, 0.f, 0.f, 0.f};
    bf16x8 At[4][2], B0[2][2], B1[2][2];
    const char* cA = (const char*)g.A + (size_t)cur.pm * tstep; const char* cB = (const char*)g.Bt + (size_t)cur.pn * tstep;
    S.a_ready(cur);
    if constexpr (SP2) {
        PG8_STAGE(PG8_SB(0, 0), cB, voffB); PG8_STAGE(PG8_SB(0, 1), cB + hstep, voffB); PG8_STAGE(PG8_SA(0, 0), cA, voffA); PG8_STAGE(PG8_SA(0, 1), cA + hstep, voffA);
        if (wr == 1) PG8_BAR;
        PG8_WAIT_V(2); PG8_BAR;
        PG8_STAGE(PG8_SB(1, 0), cB + kstep, voffB); PG8_STAGE(PG8_SA(1, 0), cA + kstep, voffA); PG8_STAGE(PG8_SB(1, 1), cB + hstep + kstep, voffB);
        PG8_WAIT_V(6); PG8_BAR;
    } else {
        PG8_STAGE(PG8_SB(0, 0), cB, voffB); PG8_STAGE(PG8_SA(0, 0), cA, voffA); PG8_STAGE(PG8_SB(0, 1), cB + hstep, voffB); PG8_STAGE(PG8_SA(0, 1), cA + hstep, voffA);
        if (wr == 1) PG8_BAR;
        PG8_WAIT_V(4); PG8_BAR;
        PG8_STAGE(PG8_SB(1, 0), cB + kstep, voffB); PG8_STAGE(PG8_SA(1, 0), cA + kstep, voffA); PG8_STAGE(PG8_SB(1, 1), cB + hstep + kstep, voffB);
        PG8_WAIT_V(6); PG8_BAR;
    }
    for (;;) {
        const bool has_next = S.next(ui + 1, nxt);
        const char* nA = has_next ? (const char*)g.A + (size_t)nxt.pm * tstep : cA; const char* nB = has_next ? (const char*)g.Bt + (size_t)nxt.pn * tstep : cB;
        for (int t = 0; t < nt; t += 2) {
            const bool last = (t == nt - 2);
            const char* a1 = cA + (size_t)(t + 1) * kstep;
            const char* a2 = last ? nA : cA + (size_t)(t + 2) * kstep; const char* b2 = last ? nB : cB + (size_t)(t + 2) * kstep;
            const char* a3 = a2 + kstep; const char* b3 = b2 + kstep;
            if (last && has_next) S.a_ready(nxt);
            if constexpr (SP2) {
            PG8_LDB(B0, 0, 0); PG8_LDB(B1, 0, 1); PG8_SCHED; PG8_LDA(At, 0, 0); PG8_STAGE(PG8_SA(1, 1), a1 + hstep, voffA);
            PG8_WAIT_V(8); PG8_WAIT_L(0); PG8_BAR; PG8_MMA(0, 0, At, B0); PG8_MMA(0, 1, At, B1); PG8_BAR; PG8_SCHED;
            PG8_LDA(At, 0, 1); PG8_STAGE(PG8_SB(0, 0), b2, voffB); PG8_STAGE(PG8_SB(0, 1), b2 + hstep, voffB); PG8_STAGE(PG8_SA(0, 0), a2, voffA);
            PG8_WAIT_V(8); PG8_WAIT_L(0); PG8_BAR; PG8_MMA(1, 0, At, B0); PG8_MMA(1, 1, At, B1); PG8_BAR; PG8_SCHED;
            PG8_LDB(B0, 1, 0); PG8_LDB(B1, 1, 1); PG8_SCHED; PG8_LDA(At, 1, 0); PG8_STAGE(PG8_SA(0, 1), a2 + hstep, voffA);
            PG8_WAIT_V(8); PG8_WAIT_L(0); PG8_BAR; PG8_MMA(0, 0, At, B0); PG8_MMA(0, 1, At, B1); PG8_BAR; PG8_SCHED;
            PG8_LDA(At, 1, 1); PG8_STAGE(PG8_SB(1, 0), b3, voffB); PG8_STAGE(PG8_SB(1, 1), b3 + hstep, voffB); PG8_STAGE(PG8_SA(1, 0), a3, voffA);
            PG8_WAIT_V(8); PG8_WAIT_L(0); PG8_BAR; PG8_MMA(1, 0, At, B0); PG8_MMA(1, 1, At, B1); PG8_BAR; PG8_SCHED;
            } else {
            PG8_LDB(B0, 0, 0); PG8_SCHED; PG8_LDA(At, 0, 0); PG8_STAGE(PG8_SA(1, 1), a1 + hstep, voffA);
            PG8_WAIT_L(8); PG8_BAR; PG8_WAIT_L(0); PG8_MMA(0, 0, At, B0); PG8_BAR; PG8_SCHED;
            PG8_LDB(B1, 0, 1); PG8_STAGE(PG8_SB(0, 0), b2, voffB);
            PG8_BAR; PG8_WAIT_L(0); PG8_MMA(0, 1, At, B1); PG8_BAR;
            PG8_LDA(At, 0, 1); PG8_STAGE(PG8_SA(0, 0), a2, voffA);
            PG8_BAR; PG8_WAIT_L(0); PG8_MMA(1, 0, At, B0); PG8_BAR; PG8_SCHED;
            PG8_STAGE(PG8_SB(0, 1), b2 + hstep, voffB);
            PG8_WAIT_V(6); PG8_BAR; PG8_MMA(1, 1, At, B1); PG8_BAR;
            PG8_LDB(B0, 1, 0); PG8_SCHED; PG8_LDA(At, 1, 0); PG8_STAGE(PG8_SA(0, 1), a2 + hstep, voffA);
            PG8_WAIT_L(8); PG8_BAR; PG8_WAIT_L(0); PG8_MMA(0, 0, At, B0); PG8_BAR; PG8_SCHED;
            PG8_LDB(B1, 1, 1); PG8_STAGE(PG8_SB(1, 0), b3, voffB);
            PG8_BAR; PG8_WAIT_L(0); PG8_MMA(0, 1, At, B1); PG8_BAR;
            PG8_LDA(At, 1, 1); PG8_STAGE(PG8_SA(1, 0), a3, voffA);
            PG8_BAR; PG8_WAIT_L(0); PG8_MMA(1, 0, At, B0); PG8_BAR; PG8_SCHED;
            PG8_STAGE(PG8_SB(1, 1), b3 + hstep, voffB);
            PG8_WAIT_V(6); PG8_BAR; PG8_MMA(1, 1, At, B1); PG8_BAR;
            }
        }
        if constexpr (ALIGN_EPI) { if (wr == 0) PG8_BAR; }
        if constexpr (!Epi::AFTER_DRAIN) { E(acc, cur, wr, wc, fr, fq); S.done(cur); }
        if (!has_next) break;
#pragma unroll
        for (int a = 0; a < 2; ++a)
#pragma unroll
            for (int b = 0; b < 2; ++b)
#pragma unroll
                for (int m = 0; m < 4; ++m)
#pragma unroll
                    for (int n = 0; n < 2; ++n) acc[a][b][m][n] = (f32x4){0.f, 0.f, 0.f, 0.f};
        cur = nxt; cA = nA; cB = nB; ++ui;
        if constexpr (ALIGN_EPI) { if (wr == 1) PG8_BAR; }
    }
    PG8_WAIT_V(0);
    if constexpr (!ALIGN_EPI) { if (wr == 0) PG8_BAR; }
    PG8_BAR;
    if constexpr (Epi::AFTER_DRAIN) { E.fused(acc, cur, wr, wc, fr, fq, lds, wid, lane); S.done(cur); }
#undef PG8_SA
#undef PG8_SB
#undef PG8_STAGE
#undef PG8_LDA
#undef PG8_LDB
#undef PG8_MMA
#undef PG8_WAIT_V
#undef PG8_WAIT_L
#undef PG8_BAR
#undef PG8_SCHED
}
}
constexpr int NB = 4, SEQ = 8192, DM = 1024, NTOK = NB * SEQ;
constexpr int HY_N = 2848, HY_NP = 3072;
constexpr int C_KV = 512, C_GATE = 1280, C_Z = 1304, C_XBC = 1816, C_DT = 2840;
constexpr int GDN_N = 4112, GDN_NP = 4352;
constexpr int FF = 2816, FF2 = 5632;
constexpr int NCMP = 511, NCMP_P = 512;
constexpr float NORM_EPS = 1e-6f;

constexpr size_t MiB = 1u << 20;
constexpr size_t WS_CTL = 0, CTL_ZERO_BYTES = 1 * MiB;
constexpr size_t WS_W_HYIN = 1 * MiB, WS_W_HYOUT = 7 * MiB, WS_W_GDNIN = 9 * MiB, WS_W_GDNOUT = 18 * MiB;
constexpr size_t WS_W_UP0 = 20 * MiB, WS_W_UP1 = 31 * MiB, WS_W_DN0 = 42 * MiB, WS_W_DN1 = 48 * MiB;
constexpr size_t WS_ROPE = 54 * MiB;
constexpr size_t WS_HN = 56 * MiB;
constexpr size_t WS_PROJ = 120 * MiB;
constexpr size_t WS_SIDE = 312 * MiB;
constexpr size_t WS_XBC = 316 * MiB;
constexpr size_t WS_MIXIN = 380 * MiB;
constexpr size_t WS_DT = 444 * MiB;
constexpr size_t WS_ACS = 445 * MiB;
constexpr size_t WS_ST = 446 * MiB;
constexpr size_t WS_KC = 478 * MiB, WS_VC = 479 * MiB;
constexpr size_t WS_MIX = 120 * MiB;
constexpr int FH = NTOK / 2;
constexpr size_t WS_U = 120 * MiB;
constexpr size_t WS_ACT = 296 * MiB;
constexpr size_t WS_F = 384 * MiB;
constexpr size_t WS_QKV = 120 * MiB;
constexpr size_t WS_Z1 = 312 * MiB;
constexpr size_t WS_SIDE2 = 376 * MiB;
constexpr size_t WS_QN = 56 * MiB;
constexpr size_t WS_KN = 378 * MiB, WS_VN = 442 * MiB;
constexpr size_t WS_BETA = 506 * MiB, WS_G = 507 * MiB;
constexpr size_t WS_GW = 120 * MiB;
constexpr size_t WS_GAQK = 184 * MiB;
constexpr size_t WS_GUT = 216 * MiB;
constexpr size_t WS_GEG = 508 * MiB, WS_GEGL = 509 * MiB, WS_GGL = 510 * MiB;
constexpr size_t WS_O1 = 442 * MiB;
constexpr size_t WS_GIN = 216 * MiB;
constexpr size_t WS_MIX1 = 312 * MiB;
constexpr size_t WS_END = 511 * MiB;
constexpr int CW_BAR = 4096;

constexpr int LDS_BYTES = 147456;
constexpr int MISC_OFF = 146944;
constexpr int PTR_OFF = MISC_OFF + 64;

#define GAS __attribute__((address_space(1)))
#define LAS __attribute__((address_space(3)))
typedef unsigned short bf16;
typedef unsigned v4u __attribute__((ext_vector_type(4)));
typedef unsigned v2u __attribute__((ext_vector_type(2)));
typedef float f32x4 __attribute__((ext_vector_type(4)));
typedef GAS unsigned gu32;
#define RLX_AGENT __ATOMIC_RELAXED, __HIP_MEMORY_SCOPE_AGENT
#define LDS_WAIT() asm volatile("s_waitcnt lgkmcnt(0)" ::: "memory")
#define VM_WAIT() asm volatile("s_waitcnt vmcnt(0)" ::: "memory")
__device__ __forceinline__ unsigned f2bf(float f) { unsigned u = __builtin_bit_cast(unsigned, f); return (u + 0x7fffu + ((u >> 16) & 1u)) >> 16; }
__device__ __forceinline__ unsigned pk2(float lo, float hi) { return f2bf(lo) | (f2bf(hi) << 16); }
__device__ __forceinline__ float bf2f(unsigned short v) { return __builtin_bit_cast(float, ((unsigned)v) << 16); }
__device__ __forceinline__ float bflo(unsigned u) { return __builtin_bit_cast(float, u << 16); }
__device__ __forceinline__ float bfhi(unsigned u) { return __builtin_bit_cast(float, u & 0xffff0000u); }
template <int CTRL> __device__ __forceinline__ float dppf(float v) { return __builtin_bit_cast(float, __builtin_amdgcn_update_dpp(0, __builtin_bit_cast(int, v), CTRL, 0xF, 0xF, false)); }
template <int CTRL> __device__ __forceinline__ unsigned dppu(unsigned v) { return (unsigned)__builtin_amdgcn_update_dpp(0, (int)v, CTRL, 0xF, 0xF, false); }
#define DPP_XOR1 0xB1
#define DPP_XOR2 0x4E
#define DPP_ROR4 0x124
#define DPP_ROR8 0x128
__device__ __forceinline__ void swap16(float v, float& a, float& b) { const unsigned u = __builtin_bit_cast(unsigned, v); auto r = __builtin_amdgcn_permlane16_swap(u, u, false, false); const unsigned r0 = r[0], r1 = r[1]; a = __builtin_bit_cast(float, r0); b = __builtin_bit_cast(float, r1); }
__device__ __forceinline__ void swap32(float v, float& a, float& b) { const unsigned u = __builtin_bit_cast(unsigned, v); auto r = __builtin_amdgcn_permlane32_swap(u, u, false, false); const unsigned r0 = r[0], r1 = r[1]; a = __builtin_bit_cast(float, r0); b = __builtin_bit_cast(float, r1); }
__device__ __forceinline__ float x16_sum(float v) { float a, b; swap16(v, a, b); return a + b; }
__device__ __forceinline__ float x32_sum(float v) { float a, b; swap32(v, a, b); return a + b; }
__device__ __forceinline__ float x16_max(float v) { float a, b; swap16(v, a, b); return fmaxf(a, b); }
__device__ __forceinline__ float x32_max(float v) { float a, b; swap32(v, a, b); return fmaxf(a, b); }
__device__ __forceinline__ float row_sum16(float v) { v += dppf<DPP_XOR1>(v); v += dppf<DPP_XOR2>(v); v += dppf<DPP_ROR4>(v); v += dppf<DPP_ROR8>(v); return v; }
__device__ __forceinline__ float wave_sum(float v) { v = row_sum16(v); v = x16_sum(v); return x32_sum(v); }
__device__ __forceinline__ float wave_max(float v) { v = fmaxf(v, dppf<DPP_XOR1>(v)); v = fmaxf(v, dppf<DPP_XOR2>(v)); v = fmaxf(v, dppf<DPP_ROR4>(v)); v = fmaxf(v, dppf<DPP_ROR8>(v)); v = x16_max(v); return x32_max(v); }
__device__ __forceinline__ float siluf(float x) { return x / (1.f + __expf(-x)); }
__device__ __forceinline__ float sigmf(float x) { return 1.f / (1.f + __expf(-x)); }
__device__ __forceinline__ float softplusf(float x) { return fmaxf(x, 0.f) + log1pf(__expf(-fabsf(x))); }
#define XB_TMO      128
#define XB_XCNT(j)  (256  + 64 * (j))
#define XB_XSUB(j)  (1280 + 64 * (j))
#define XB_XGEN(j)  (2304 + 64 * (j))
#define XB_TOP      3328
#define XB_TOPGEN   3392
#define XCD_BAR_WORDS 3456
#define XB_SPIN_CAP (1u << 18)

__device__ __forceinline__ unsigned xb_ld(unsigned* p)              { return __hip_atomic_load(p, __ATOMIC_RELAXED, __HIP_MEMORY_SCOPE_AGENT); }
__device__ __forceinline__ unsigned xb_add(unsigned* p, unsigned v) { return __hip_atomic_fetch_add(p, v, __ATOMIC_RELAXED, __HIP_MEMORY_SCOPE_AGENT); }
__device__ __forceinline__ unsigned xb_xcc_id() { return (unsigned)__builtin_amdgcn_s_getreg((3 << 11) | 20) & 0xFu; }
#define XB_SPIN(cond, bar) do { unsigned _sp = 0; while (cond) { __builtin_amdgcn_s_sleep(1); \
    if ((++_sp & 255u) == 0u) { if (xb_ld(&(bar)[XB_TMO])) break; if (_sp > XB_SPIN_CAP) { atomicAdd(&(bar)[XB_TMO], 1u); break; } } } } while (0)

struct XcdBarrier {
    unsigned* bar; unsigned x;
    volatile LAS unsigned* st;
};

__device__ __forceinline__ XcdBarrier xcd_barrier_post(unsigned* bar, volatile LAS unsigned* st) {
    XcdBarrier b; b.bar = bar; b.x = xb_xcc_id(); b.st = st;
    if (threadIdx.x == 0) (void)xb_add(&bar[XB_XCNT(b.x)], 1u);
    return b;
}
__device__ __forceinline__ void xcd_barrier_complete(unsigned* bar, unsigned x, unsigned& nloc, unsigned& nx) {
    const unsigned G = gridDim.x * gridDim.y * gridDim.z;
    unsigned sum, cnt, mine, sp = 0u;
    for (;;) {
        sum = 0u; cnt = 0u; mine = 0u;
#pragma unroll
        for (unsigned j = 0; j < 16; ++j) { const unsigned c = xb_ld(&bar[XB_XCNT(j)]); sum += c; cnt += (c > 0u) ? 1u : 0u; mine = (j == x) ? c : mine; }
        if (sum == G) break;
        __builtin_amdgcn_s_sleep(1);
        if ((++sp & 255u) == 0u) { if (xb_ld(&bar[XB_TMO])) break; if (sp > XB_SPIN_CAP) { atomicAdd(&bar[XB_TMO], 1u); break; } }
    }
    nloc = mine > 0u ? mine : 1u; nx = cnt > 0u ? cnt : 1u;
}

__device__ __forceinline__ void xcd_barrier(const XcdBarrier& b) {
    asm volatile("s_waitcnt vmcnt(0)" ::: "memory");
    __syncthreads();
    if (threadIdx.x == 0) {
        unsigned* bar = b.bar;
        __builtin_amdgcn_s_waitcnt(0);
        unsigned nloc = b.st[0], nx = b.st[1];
        if (nloc == 0u) { xcd_barrier_complete(bar, b.x, nloc, nx); b.st[0] = nloc; b.st[1] = nx; }
        const unsigned old = xb_add(&bar[XB_XSUB(b.x)], 1u);
        const unsigned gen = old / nloc;
        if (old + 1u == (gen + 1u) * nloc) {
            __builtin_amdgcn_fence(__ATOMIC_RELEASE, "agent");
            asm volatile("s_waitcnt vmcnt(0)" ::: "memory");
            const unsigned og = xb_add(&bar[XB_TOP], 1u);
            const unsigned tg = og / nx;
            if (og + 1u == (tg + 1u) * nx) xb_add(&bar[XB_TOPGEN], 1u);
            else XB_SPIN(xb_ld(&bar[XB_TOPGEN]) == tg, bar);
            __builtin_amdgcn_fence(__ATOMIC_ACQUIRE, "agent");
            xb_add(&bar[XB_XGEN(b.x)], 1u);
            asm volatile("s_waitcnt vmcnt(0)" ::: "memory");
        } else {
            XB_SPIN(xb_ld(&bar[XB_XGEN(b.x)]) == gen, bar);
            __builtin_amdgcn_fence(__ATOMIC_ACQUIRE, "agent");
            asm volatile("s_waitcnt vmcnt(0)" ::: "memory");
        }
    }
    __syncthreads();
}

#define EPI_LOOP(BODY) \
    _Pragma("unroll") for (int ai = 0; ai < 2; ++ai) _Pragma("unroll") for (int m = 0; m < 4; ++m) { const int row = u.pm * 256 + ai * 128 + wr * 64 + m * 16 + fr; \
    _Pragma("unroll") for (int bj = 0; bj < 2; ++bj) _Pragma("unroll") for (int n = 0; n < 2; ++n) { const int col = u.pn * 256 + bj * 128 + wc * 32 + n * 16 + 4 * fq; const f32x4 v = acc[ai][bj][m][n]; BODY } }

struct EpiF32 {
    static constexpr bool PERM = false, AFTER_DRAIN = false;
    float* O; int ldc;
    __device__ __forceinline__ void operator()(const pg8::f32x4 (&acc)[2][2][4][2], const pg8::Unit& u, int wr, int wc, int fr, int fq) const {
        EPI_LOOP( *(f32x4*)(O + (size_t)row * ldc + col) = v; )
    }
};
struct EpiB16 {
    static constexpr bool PERM = false, AFTER_DRAIN = false;
    bf16* O; int ldc;
    __device__ __forceinline__ void operator()(const pg8::f32x4 (&acc)[2][2][4][2], const pg8::Unit& u, int wr, int wc, int fr, int fq) const {
        EPI_LOOP( v2u w; w.x = pk2(v[0], v[1]); w.y = pk2(v[2], v[3]); *(v2u*)(O + (size_t)row * ldc + col) = w; )
    }
};
struct EpiHyIn {
    static constexpr bool PERM = false, AFTER_DRAIN = false;
    bf16* P; float* side;
    __device__ __forceinline__ void operator()(const pg8::f32x4 (&acc)[2][2][4][2], const pg8::Unit& u, int wr, int wc, int fr, int fq) const {
        EPI_LOOP( v2u w; w.x = pk2(v[0], v[1]); w.y = pk2(v[2], v[3]); *(v2u*)(P + (size_t)row * HY_NP + col) = w;
                  if (col >= C_GATE && col < C_Z) *(f32x4*)(side + (size_t)row * 32 + (col - C_GATE)) = v;
                  if (col >= C_DT && col < HY_N) *(f32x4*)(side + (size_t)row * 32 + 24 + (col - C_DT)) = v; )
    }
};
struct EpiGdnIn {
    static constexpr bool PERM = false, AFTER_DRAIN = false;
    bf16* QKV; bf16* Z; float* side;
    __device__ __forceinline__ void operator()(const pg8::f32x4 (&acc)[2][2][4][2], const pg8::Unit& u, int wr, int wc, int fr, int fq) const {
        EPI_LOOP( if (col < 3072) { v2u w; w.x = pk2(v[0], v[1]); w.y = pk2(v[2], v[3]); *(v2u*)(QKV + (size_t)row * 3072 + col) = w; }
                  else if (col < 4096) { v2u w; w.x = pk2(v[0], v[1]); w.y = pk2(v[2], v[3]); *(v2u*)(Z + (size_t)row * 1024 + (col - 3072)) = w; }
                  else if (col < GDN_N) *(f32x4*)(side + (size_t)row * 16 + (col - 4096)) = v; )
    }
};

struct InvFreq { float f[8]; };
struct Args { const float* in[32]; float* out; unsigned char* ws; int ph_lo, ph_hi; InvFreq ifq; };
struct Ctx {
    LAS unsigned char* lds;
    int tid, lane, wave, G, bid;
};
__device__ __forceinline__ unsigned char* ldptr(const Ctx& C, int k) {
    const LAS unsigned* t = (const LAS unsigned*)(C.lds + PTR_OFF) + 2 * k;
    const unsigned lo = __builtin_amdgcn_readfirstlane(t[0]), hi = __builtin_amdgcn_readfirstlane(t[1]);
    return (unsigned char*)(GAS unsigned char*)(((unsigned long long)hi << 32) | (unsigned long long)lo);
}
#define WSP(T, off) ((T*)(ldptr(C, 33) + (off)))
#define INP(k) ((const float*)ldptr(C, (k)))
#define OUTP() ((float*)ldptr(C, 32))

__device__ __forceinline__ void wt_item(const float* W, int K, int N, bf16* WT, LAS float* scr, int item, int lane, int nblk) {
    const int kb = item / nblk, nb = item % nblk, k0 = 64 * kb, n0 = 32 * nb;
    const int nn = n0 + (lane & 31); const bool ok = nn < N;
#pragma unroll 8
    for (int i = 0; i < 32; ++i) { const int kk = 2 * i + (lane >> 5); scr[kk * 33 + (lane & 31)] = ok ? W[(size_t)(k0 + kk) * N + nn] : 0.f; }
    LDS_WAIT();
    const int c = lane & 7;
#pragma unroll
    for (int j = 0; j < 4; ++j) { const int n = (lane >> 3) + 8 * j; const LAS float* s = scr + (8 * c) * 33 + n;
        v4u o; o.x = pk2(s[0 * 33], s[1 * 33]); o.y = pk2(s[2 * 33], s[3 * 33]); o.z = pk2(s[4 * 33], s[5 * 33]); o.w = pk2(s[6 * 33], s[7 * 33]);
        *(v4u*)(WT + (size_t)(n0 + n) * K + k0 + 8 * c) = o; }
    LDS_WAIT();
}
__device__ __forceinline__ void wt_matrix(const Ctx& C, const float* W, int K, int N, int Np, bf16* WT) {
    LAS float* scr = (LAS float*)(C.lds + C.wave * 16384);
    const int gw = C.bid * 8 + C.wave, NGW = C.G * 8, nblk = Np / 32, items = (K / 64) * nblk;
    for (int it = gw; it < items; it += NGW) wt_item(W, K, N, WT, scr, it, C.lane, nblk);
}
__device__ __forceinline__ void rms_row_to_bf16(const float* xrow, const float* g, bf16* orow, int lane) {
    const f32x4* xr = (const f32x4*)xrow + lane; const f32x4* gr = (const f32x4*)g + lane;
    f32x4 v[4]; float s = 0.f;
#pragma unroll
    for (int j = 0; j < 4; ++j) { v[j] = xr[64 * j]; s += (v[j].x * v[j].x + v[j].y * v[j].y) + (v[j].z * v[j].z + v[j].w * v[j].w); }
    const float rs = 1.f / sqrtf(wave_sum(s) * (1.f / DM) + NORM_EPS);
    v2u* o8 = (v2u*)orow + lane;
#pragma unroll
    for (int j = 0; j < 4; ++j) { const f32x4 gg = gr[64 * j]; v2u w; w.x = pk2(v[j].x * rs * gg.x, v[j].y * rs * gg.y); w.y = pk2(v[j].z * rs * gg.z, v[j].w * rs * gg.w); o8[64 * j] = w; }
}
__device__ __forceinline__ void sincos_acc(float af, float& sn, float& cs) {
    const double a = (double)af;
    const double q = rint(a * 0.63661977236758134308);
    double r = fma(-q, 1.57079632679489655800e+00, a); r = fma(-q, 6.12323399573676603587e-17, r);
    const int n = ((int)q) & 3;
    const double r2 = r * r;
    double s = -1.0 / 6227020800.0; s = s * r2 + 1.0 / 39916800.0; s = s * r2 - 1.0 / 362880.0; s = s * r2 + 1.0 / 5040.0; s = s * r2 - 1.0 / 120.0; s = s * r2 + 1.0 / 6.0; s = r - r * r2 * s;
    double c = 1.0 / 87178291200.0; c = c * r2 - 1.0 / 479001600.0; c = c * r2 + 1.0 / 3628800.0; c = c * r2 - 1.0 / 40320.0; c = c * r2 + 1.0 / 720.0; c = c * r2 - 1.0 / 24.0; c = c * r2 + 0.5; c = 1.0 - r2 * c;
    double so, co;
    if (n == 0) { so = s; co = c; } else if (n == 1) { so = c; co = -s; } else if (n == 2) { so = -s; co = -c; } else { so = -c; co = s; }
    sn = (float)so; cs = (float)co;
}
__device__ __forceinline__ void phase_prologue(const Ctx& C) {
    const LAS float* ifq = (const LAS float*)(C.lds + PTR_OFF + 34 * 8);
    wt_matrix(C, INP(6), DM, HY_N, HY_NP, WSP(bf16, WS_W_HYIN));
    wt_matrix(C, INP(7), DM, DM, DM, WSP(bf16, WS_W_HYOUT));
    wt_matrix(C, INP(22), DM, GDN_N, GDN_NP, WSP(bf16, WS_W_GDNIN));
    wt_matrix(C, INP(27), DM, DM, DM, WSP(bf16, WS_W_GDNOUT));
    wt_matrix(C, INP(28), DM, FF2, FF2, WSP(bf16, WS_W_UP0));
    wt_matrix(C, INP(28) + (size_t)DM * FF2, DM, FF2, FF2, WSP(bf16, WS_W_UP1));
    wt_matrix(C, INP(31), FF, DM, DM, WSP(bf16, WS_W_DN0));
    wt_matrix(C, INP(31) + (size_t)FF * DM, FF, DM, DM, WSP(bf16, WS_W_DN1));
    { const int* pos = (const int*)INP(1); float* tab = WSP(float, WS_ROPE);
      for (int idx = C.bid * 512 + C.tid; idx < NTOK * 8; idx += C.G * 512) { const int tok = idx >> 3, i = idx & 7;
          float fr = ifq[0];
#pragma unroll
          for (int k = 1; k < 8; ++k) fr = (i == k) ? ifq[k] : fr;
          const float ang = (float)pos[tok] * fr; float sn, cs; sincos_acc(ang, sn, cs); tab[tok * 16 + i] = cs; tab[tok * 16 + 8 + i] = sn; } }
    { const int gw = C.bid * 8 + C.wave, NGW = C.G * 8; bf16* HN = WSP(bf16, WS_HN);
      for (int m = gw; m < NTOK; m += NGW) rms_row_to_bf16(INP(0) + (size_t)m * DM, INP(2), HN + (size_t)m * DM, C.lane); }
}

__device__ __forceinline__ void phase_res(const Ctx& C, const float* xin, float* xout, const float* mix, int row0, int nrows, const float* gpost, const float* gnext, bf16* HN) {
    const int gw = C.bid * 8 + C.wave, NGW = C.G * 8, lane = C.lane;
    for (int r = gw; r < nrows; r += NGW) {
        const size_t grow = (size_t)(row0 + r);
        const f32x4* mr = (const f32x4*)(mix + (size_t)r * DM) + lane; const f32x4* xr = (const f32x4*)(xin + grow * DM) + lane;
        f32x4 v[4]; float s = 0.f;
#pragma unroll
        for (int j = 0; j < 4; ++j) { v[j] = mr[64 * j]; s += (v[j].x * v[j].x + v[j].y * v[j].y) + (v[j].z * v[j].z + v[j].w * v[j].w); }
        const float rs = 1.f / sqrtf(wave_sum(s) * (1.f / DM) + NORM_EPS);
        float s2 = 0.f;
#pragma unroll
        for (int j = 0; j < 4; ++j) { const f32x4 gg = ((const f32x4*)gpost + lane)[64 * j]; const f32x4 xx = xr[64 * j];
            v[j].x = xx.x + v[j].x * rs * gg.x; v[j].y = xx.y + v[j].y * rs * gg.y; v[j].z = xx.z + v[j].z * rs * gg.z; v[j].w = xx.w + v[j].w * rs * gg.w;
            s2 += (v[j].x * v[j].x + v[j].y * v[j].y) + (v[j].z * v[j].z + v[j].w * v[j].w);
            ((f32x4*)(xout + grow * DM) + lane)[64 * j] = v[j]; }
        if (gnext) { const float rs2 = 1.f / sqrtf(wave_sum(s2) * (1.f / DM) + NORM_EPS); v2u* o8 = (v2u*)(HN + grow * DM) + lane;
#pragma unroll
            for (int j = 0; j < 4; ++j) { const f32x4 gg = ((const f32x4*)gnext + lane)[64 * j]; v2u w; w.x = pk2(v[j].x * rs2 * gg.x, v[j].y * rs2 * gg.y); w.y = pk2(v[j].z * rs2 * gg.z, v[j].w * rs2 * gg.w); o8[64 * j] = w; } }
    }
}

__device__ __forceinline__ void phase_compress(const Ctx& C) {
    LAS float* X = (LAS float*)C.lds;
    LAS float* PE = X + 144 * 64;
    LAS float* HID = PE + 32 * 64;
    const bf16* P = WSP(bf16, WS_PROJ);
    for (int item = C.bid; item < 2 * NB * 2 * 64; item += C.G) {
        const int which = item & 1, g = (item >> 1) & 1, b = (item >> 2) & 3, nt = item >> 4;
        const float* pe = INP(8 + which); const float* w1 = INP(which ? 13 : 10); const float* b1 = INP(which ? 14 : 11); const float* w2 = INP(which ? 15 : 12);
        bf16* OUT = WSP(bf16, which ? WS_VC : WS_KC);
        const int col0 = C_KV + which * 128 + g * 64, t0 = nt * 128;
        for (int e = C.tid; e < 144 * 64; e += 512) { const int tt = e >> 6, d = e & 63, t = t0 + tt; X[e] = t < SEQ ? bf2f(P[(size_t)(b * SEQ + t) * HY_NP + col0 + d]) : 0.f; }
        for (int e = C.tid; e < 32 * 64; e += 512) PE[e] = pe[e];
        __syncthreads();
        const int nl = C.tid >> 6, c = C.tid & 63, n = nt * 8 + nl;
        float a = b1[c];
        for (int l = 0; l < 32; ++l) {
            const LAS float* xr = X + (16 * nl + l) * 64; const LAS float* pr = PE + l * 64; const float* wr = w1 + (size_t)(l * 64) * 64 + c;
#pragma unroll 8
            for (int d = 0; d < 64; ++d) a += (xr[d] + pr[d]) * wr[d * 64];
        }
        HID[nl * 64 + c] = siluf(a);
        __syncthreads();
        float o = 0.f;
#pragma unroll 8
        for (int j = 0; j < 64; ++j) o += HID[nl * 64 + j] * w2[j * 64 + c];
        OUT[((size_t)(b * 2 + g) * NCMP_P + n) * 64 + c] = (bf16)(n < NCMP ? f2bf(o) : 0u);
        __syncthreads();
    }
}

__device__ __forceinline__ void phase_ssd_s2(const Ctx& C) {
    float* ST = WSP(float, WS_ST); const float* ACS = WSP(float, WS_ACS);
    for (int idx = C.bid * 512 + C.tid; idx < NB * 8 * 64 * 128; idx += C.G * 512) {
        const int pn = idx & 8191, h = (idx >> 13) & 7, b = idx >> 16;
        float hs = 0.f;
        for (int c = 0; c < 32; ++c) { float* p = ST + (((size_t)(b * 32 + c) * 8 + h) * 8192) + pn; const float t = *p; *p = hs;
            hs = hs * __expf(ACS[((size_t)b * SEQ + c * 256 + 255) * 8 + h]) + t; }
    }
}
typedef short bf16x8_t __attribute__((ext_vector_type(8)));
typedef short s16x4_t __attribute__((ext_vector_type(4)));
typedef float f32x2_t __attribute__((ext_vector_type(2)));
typedef __bf16 bf16x2_t __attribute__((ext_vector_type(2)));
__device__ __forceinline__ unsigned cvtpk(float lo, float hi) { f32x2_t v = {lo, hi}; bf16x2_t b = __builtin_convertvector(v, bf16x2_t); return __builtin_bit_cast(unsigned, b); }
__device__ __forceinline__ s16x4_t lds_tr16(const LAS unsigned char* p) { return __builtin_bit_cast(s16x4_t, __builtin_amdgcn_ds_read_tr16_b64_v4i16((LAS s16x4_t*)p)); }

constexpr int NSA_RS = 144;
constexpr int NSA_TILE = 64 * NSA_RS;
constexpr int NSA_BUF = 2 * NSA_TILE;
constexpr int NSA_IMPQ = 2 * NSA_BUF;
constexpr int NSA_IMPL = NSA_IMPQ + 32768;
constexpr int NSA_SELM = NSA_IMPL + 32768;
constexpr float NSA_C2 = 0.125f * 1.4426950408889634f;

template <int MODE>
__device__ __forceinline__ void nsa_pass(LAS unsigned char* lds, const bf16* Kg, const bf16* Vg, const size_t pitch, const int tile_lo, const int tile_hi,
                                         const bf16x8_t (&qf)[2][2], float (&m)[2], float (&l)[2], f32x4 (&O)[4][2], const float (&invl)[2],
                                         const int t_tok, const unsigned long long sel_lo, const unsigned long long sel_hi, LAS float* impq, LAS float* impl, int tid) {
    asm volatile("" : "+v"(tid));
    const int lane = tid & 63, c16 = lane & 15, g4 = lane >> 4;
    const int srow = tid >> 3, sch = tid & 7;
    const int ncv = t_tok >= 31 ? (t_tok - 15) >> 4 : 0;
    v4u kr, vr;
    { const size_t off = (size_t)(tile_lo * 64 + srow) * pitch + sch * 8; kr = *(const v4u*)(Kg + off); vr = *(const v4u*)(Vg + off); }
    { LAS unsigned char* b0 = lds + (tile_lo & 1) * NSA_BUF + srow * NSA_RS + sch * 16; *(LAS v4u*)b0 = kr; *(LAS v4u*)(b0 + NSA_TILE) = vr; }
    __syncthreads();
#pragma unroll 1
    for (int tile = tile_lo; tile <= tile_hi; ++tile) {
        const bool more = tile < tile_hi;
        if (more) { const size_t off = (size_t)((tile + 1) * 64 + srow) * pitch + sch * 8; kr = *(const v4u*)(Kg + off); vr = *(const v4u*)(Vg + off); }
        const LAS unsigned char* Kb = lds + (tile & 1) * NSA_BUF; const LAS unsigned char* Vb = Kb + NSA_TILE;
        bool act = true;
        if (MODE == 2) { const unsigned long long wsel = (tile & 64) ? sel_hi : sel_lo; act = ((wsel >> (tile & 63)) & 1ull) != 0ull; }
        if (MODE != 2 || __any(act)) {
            f32x4 s[4][2];
#pragma unroll
            for (int rt = 0; rt < 4; ++rt) {
                const bf16x8_t k0 = *(const LAS bf16x8_t*)(Kb + (16 * rt + c16) * NSA_RS + 16 * g4), k1 = *(const LAS bf16x8_t*)(Kb + (16 * rt + c16) * NSA_RS + 64 + 16 * g4);
#pragma unroll
                for (int ct = 0; ct < 2; ++ct) { f32x4 a = {0.f, 0.f, 0.f, 0.f}; a = __builtin_amdgcn_mfma_f32_16x16x32_bf16(k0, qf[ct][0], a, 0, 0, 0); s[rt][ct] = __builtin_amdgcn_mfma_f32_16x16x32_bf16(k1, qf[ct][1], a, 0, 0, 0); }
            }
#pragma unroll
            for (int rt = 0; rt < 4; ++rt)
#pragma unroll
                for (int r = 0; r < 4; ++r) { const int key = tile * 64 + 16 * rt + 4 * g4 + r; bool ok;
                    if (MODE <= 1) ok = key < ncv; else if (MODE == 2) ok = act && key <= t_tok; else ok = key <= t_tok && key >= t_tok - 511;
#pragma unroll
                    for (int ct = 0; ct < 2; ++ct) s[rt][ct][r] = ok ? s[rt][ct][r] * NSA_C2 : -INFINITY; }
            if (MODE != 1) {
#pragma unroll
                for (int ct = 0; ct < 2; ++ct) {
                    float mx = fmaxf(fmaxf(s[0][ct][0], s[0][ct][1]), fmaxf(s[0][ct][2], s[0][ct][3]));
#pragma unroll
                    for (int rt = 1; rt < 4; ++rt) mx = fmaxf(mx, fmaxf(fmaxf(s[rt][ct][0], s[rt][ct][1]), fmaxf(s[rt][ct][2], s[rt][ct][3])));
                    mx = x32_max(x16_max(mx));
                    const float mn = fmaxf(m[ct], mx), corr = __builtin_amdgcn_exp2f(m[ct] - mn); m[ct] = mn;
                    float ps = 0.f;
#pragma unroll
                    for (int rt = 0; rt < 4; ++rt)
#pragma unroll
                        for (int r = 0; r < 4; ++r) { const float p = __builtin_amdgcn_exp2f(s[rt][ct][r] - mn); s[rt][ct][r] = p; ps += p; }
                    l[ct] = l[ct] * corr + ps;
                    if (MODE != 0) {
#pragma unroll
                        for (int dt = 0; dt < 4; ++dt) O[dt][ct] *= corr; }
                }
            } else {
#pragma unroll
                for (int ct = 0; ct < 2; ++ct)
#pragma unroll
                    for (int rt = 0; rt < 4; ++rt)
#pragma unroll
                        for (int r = 0; r < 4; ++r) s[rt][ct][r] = __builtin_amdgcn_exp2f(s[rt][ct][r] - m[ct]) * invl[ct];
#pragma unroll
                for (int rt = 0; rt < 4; ++rt) {
                    float q4 = ((s[rt][0][0] + s[rt][0][1]) + (s[rt][0][2] + s[rt][0][3])) + ((s[rt][1][0] + s[rt][1][1]) + (s[rt][1][2] + s[rt][1][3]));
                    float l3 = s[rt][0][3] + s[rt][1][3];
                    q4 += dppf<DPP_ROR8>(q4); l3 += dppf<DPP_ROR8>(l3);
                    if (c16 < 8) { const int j0 = tile * 16 + 4 * rt + g4; impq[c16 * 128 + j0] = q4; impl[c16 * 128 + j0] = l3; }
                }
            }
            if (MODE != 0) {
#pragma unroll
                for (int ks = 0; ks < 2; ++ks) {
                    bf16x8_t pf[2];
#pragma unroll
                    for (int ct = 0; ct < 2; ++ct) { v4u w; w.x = cvtpk(s[2 * ks][ct][0], s[2 * ks][ct][1]); w.y = cvtpk(s[2 * ks][ct][2], s[2 * ks][ct][3]);
                        w.z = cvtpk(s[2 * ks + 1][ct][0], s[2 * ks + 1][ct][1]); w.w = cvtpk(s[2 * ks + 1][ct][2], s[2 * ks + 1][ct][3]); pf[ct] = __builtin_bit_cast(bf16x8_t, w); }
#pragma unroll
                    for (int dt = 0; dt < 4; ++dt) {
                        const LAS unsigned char* va = Vb + (32 * ks + 4 * g4 + (c16 >> 2)) * NSA_RS + (16 * dt + 4 * (c16 & 3)) * 2;
                        const s16x4_t lo = lds_tr16(va), hi = lds_tr16(va + 16 * NSA_RS);
                        const bf16x8_t vf = {lo[0], lo[1], lo[2], lo[3], hi[0], hi[1], hi[2], hi[3]};
#pragma unroll
                        for (int ct = 0; ct < 2; ++ct) O[dt][ct] = __builtin_amdgcn_mfma_f32_16x16x32_bf16(vf, pf[ct], O[dt][ct], 0, 0, 0);
                    }
                }
            }
        }
        if (more) { LAS unsigned char* b1 = lds + ((tile + 1) & 1) * NSA_BUF + srow * NSA_RS + sch * 16; *(LAS v4u*)b1 = kr; *(LAS v4u*)(b1 + NSA_TILE) = vr; }
        __syncthreads();
    }
}

__device__ __forceinline__ void phase_nsa(const Ctx& C) {
    const bf16* P = WSP(bf16, WS_PROJ); const bf16* KC = WSP(bf16, WS_KC); const bf16* VC = WSP(bf16, WS_VC); const float* side = WSP(float, WS_SIDE);
    bf16* MIXIN = WSP(bf16, WS_MIXIN);
#pragma unroll 1
    for (int idx = C.bid; idx < 1024; idx += C.G) {
        int tid = C.tid; asm volatile("" : "+v"(tid));
        const int lane = tid & 63, w = __builtin_amdgcn_readfirstlane(tid >> 6), c16 = lane & 15, g4 = lane >> 4;
        LAS float* impq = (LAS float*)(C.lds + NSA_IMPQ) + w * 1024; LAS float* impl = (LAS float*)(C.lds + NSA_IMPL) + w * 1024;
        LAS unsigned* selw = (LAS unsigned*)(C.lds + NSA_SELM) + w * 64;
        const int k4 = idx >> 8, bg = (idx & 255) >> 5, sx = idx & 31, b = bg >> 1, g = bg & 1;
        const int qt = k4 == 0 ? sx : (k4 == 1 ? 63 - sx : (k4 == 2 ? 64 + sx : 127 - sx));
        const int t0 = qt * 64, tl = t0 + 8 * w + (c16 & 7);
        const size_t tok = (size_t)b * SEQ + tl;
        const bf16* Pb = P + (size_t)b * SEQ * HY_NP;
        bf16x8_t qf[2][2];
#pragma unroll
        for (int ct = 0; ct < 2; ++ct)
#pragma unroll
            for (int ds = 0; ds < 2; ++ds) qf[ct][ds] = *(const bf16x8_t*)(P + tok * HY_NP + (g * 4 + 2 * ct + (c16 >> 3)) * 64 + 32 * ds + 8 * g4);
        float gate[2][3];
#pragma unroll
        for (int ct = 0; ct < 2; ++ct)
#pragma unroll
            for (int i = 0; i < 3; ++i) gate[ct][i] = sigmf(side[tok * 32 + (g * 4 + 2 * ct + (c16 >> 3)) * 3 + i]);
        for (int e = lane; e < 1024; e += 64) { impq[e] = 0.f; impl[e] = 0.f; }
        f32x4 OT[4][2], O[4][2];
#pragma unroll
        for (int dt = 0; dt < 4; ++dt)
#pragma unroll
            for (int ct = 0; ct < 2; ++ct) { OT[dt][ct] = (f32x4){0.f, 0.f, 0.f, 0.f}; O[dt][ct] = (f32x4){0.f, 0.f, 0.f, 0.f}; }
        float m[2], l[2], invl[2]; unsigned long long sel_lo = 0ull, sel_hi = 0ull;
        { const bf16* Kc = KC + (size_t)bg * NCMP_P * 64; const bf16* Vc = VC + (size_t)bg * NCMP_P * 64;
          const int nct = (4 * qt + 3 + 63) >> 6;
          m[0] = m[1] = -1e30f; l[0] = l[1] = 0.f; invl[0] = invl[1] = 0.f;
          nsa_pass<0>(C.lds, Kc, Vc, 64, 0, nct - 1, qf, m, l, O, invl, tl, sel_lo, sel_hi, impq, impl, tid);
#pragma unroll
          for (int ct = 0; ct < 2; ++ct) { float lt = x32_sum(x16_sum(l[ct])); invl[ct] = lt > 0.f ? 1.f / lt : 0.f; }
          nsa_pass<1>(C.lds, Kc, Vc, 64, 0, nct - 1, qf, m, l, O, invl, tl, sel_lo, sel_hi, impq, impl, tid);
#pragma unroll
          for (int dt = 0; dt < 4; ++dt)
#pragma unroll
              for (int ct = 0; ct < 2; ++ct) { OT[dt][ct] += O[dt][ct] * gate[ct][0]; O[dt][ct] = (f32x4){0.f, 0.f, 0.f, 0.f}; } }
        { LDS_WAIT();
          const int tk = lane >> 3, sub = lane & 7;
          unsigned key[16]; unsigned bits = 0u;
#pragma unroll
          for (int e = 0; e < 16; ++e) { const int j = 16 * sub + e; float v = impq[tk * 128 + j]; if (j > 0) v += impl[tk * 128 + j - 1];
              const bool forced = (j == 0) | (j == qt) | (j == qt - 1), valid = j <= qt;
              if (forced) bits |= 1u << e;
              key[e] = (valid && !forced) ? (((__builtin_bit_cast(unsigned, v) & ~127u) | (unsigned)(127 - j)) + 1u) : 0u; }
          const int nsel = 16 - (qt >= 2 ? 3 : qt + 1);
#pragma unroll 1
          for (int r = 0; r < nsel; ++r) {
              unsigned mx = key[0];
#pragma unroll
              for (int e = 1; e < 16; ++e) mx = key[e] > mx ? key[e] : mx;
              { unsigned o = dppu<DPP_XOR1>(mx); mx = o > mx ? o : mx; o = dppu<DPP_XOR2>(mx); mx = o > mx ? o : mx; o = dppu<0x141>(mx); mx = o > mx ? o : mx; }
              if (mx != 0u) {
#pragma unroll
                  for (int e = 0; e < 16; ++e) if (key[e] == mx) { key[e] = 0u; bits |= 1u << e; } }
          }
          selw[tk * 8 + sub] = bits;
          LDS_WAIT();
          const int mt = c16 & 7;
          sel_lo = (unsigned long long)((selw[mt * 8 + 0] & 0xffffu) | (selw[mt * 8 + 1] << 16)) | ((unsigned long long)((selw[mt * 8 + 2] & 0xffffu) | (selw[mt * 8 + 3] << 16)) << 32);
          sel_hi = (unsigned long long)((selw[mt * 8 + 4] & 0xffffu) | (selw[mt * 8 + 5] << 16)) | ((unsigned long long)((selw[mt * 8 + 6] & 0xffffu) | (selw[mt * 8 + 7] << 16)) << 32);
        }
        m[0] = m[1] = -1e30f; l[0] = l[1] = 0.f;
        nsa_pass<2>(C.lds, Pb + C_KV + 2 * 128 + g * 64, Pb + C_KV + 3 * 128 + g * 64, HY_NP, 0, qt, qf, m, l, O, invl, tl, sel_lo, sel_hi, impq, impl, tid);
#pragma unroll
        for (int ct = 0; ct < 2; ++ct) { float lt = x32_sum(x16_sum(l[ct])); const float sc = gate[ct][1] / lt;
#pragma unroll
            for (int dt = 0; dt < 4; ++dt) { OT[dt][ct] += O[dt][ct] * sc; O[dt][ct] = (f32x4){0.f, 0.f, 0.f, 0.f}; } }
        m[0] = m[1] = -1e30f; l[0] = l[1] = 0.f;
        nsa_pass<3>(C.lds, Pb + C_KV + 4 * 128 + g * 64, Pb + C_KV + 5 * 128 + g * 64, HY_NP, qt >= 8 ? qt - 8 : 0, qt, qf, m, l, O, invl, tl, sel_lo, sel_hi, impq, impl, tid);
#pragma unroll
        for (int ct = 0; ct < 2; ++ct) { float lt = x32_sum(x16_sum(l[ct])); const float sc = gate[ct][2] / lt;
#pragma unroll
            for (int dt = 0; dt < 4; ++dt) OT[dt][ct] += O[dt][ct] * sc; }
#pragma unroll
        for (int ct = 0; ct < 2; ++ct)
#pragma unroll
            for (int dt = 0; dt < 4; ++dt) { v2u wv; wv.x = cvtpk(OT[dt][ct][0], OT[dt][ct][1]); wv.y = cvtpk(OT[dt][ct][2], OT[dt][ct][3]);
                *(v2u*)(MIXIN + tok * 1024 + (g * 4 + 2 * ct + (c16 >> 3)) * 64 + 16 * dt + 4 * g4) = wv; }
    }
}
constexpr int SD_ACS = 0, SD_DT = 4096, SD_W = 8192, SD_TILES = 12288;
constexpr int SD_BRS = 272, SD_XRS = 528, SD_BT = 64 * SD_BRS, SD_XT = 64 * SD_XRS, SD_BUF = SD_BT + SD_XT;
static_assert(SD_TILES + 2 * SD_BUF <= 139264, "ssd LDS");

#define SSD_LOAD_TILE(LT) do { _Pragma("unroll") for (int r_ = 0; r_ < 2; ++r_) { const int e_ = tid + 512 * r_, row_ = e_ >> 4, ch_ = e_ & 15; breg[r_] = *(const v4u*)(X + (tok0 + 64 * (LT) + row_) * 1024 + 512 + g * 128 + ch_ * 8); } \
        _Pragma("unroll") for (int r_ = 0; r_ < 4; ++r_) { const int e_ = tid + 512 * r_, row_ = e_ >> 5, ch_ = e_ & 31; xreg[r_] = *(const v4u*)(X + (tok0 + 64 * (LT) + row_) * 1024 + g * 256 + ch_ * 8); } } while (0)
#define SSD_STORE_TILE(LT, BUFP, SCALE) do { _Pragma("unroll") for (int r_ = 0; r_ < 2; ++r_) { const int e_ = tid + 512 * r_, row_ = e_ >> 4, ch_ = e_ & 15; *(LAS v4u*)((BUFP) + row_ * SD_BRS + ch_ * 16) = breg[r_]; } \
        _Pragma("unroll") for (int r_ = 0; r_ < 4; ++r_) { const int e_ = tid + 512 * r_, row_ = e_ >> 5, ch_ = e_ & 31; const float sc_ = (SCALE)[(ch_ >> 3) * 256 + 64 * (LT) + row_]; const v4u v_ = xreg[r_]; v4u o_; \
            o_.x = cvtpk(bflo(v_.x) * sc_, bfhi(v_.x) * sc_); o_.y = cvtpk(bflo(v_.y) * sc_, bfhi(v_.y) * sc_); o_.z = cvtpk(bflo(v_.z) * sc_, bfhi(v_.z) * sc_); o_.w = cvtpk(bflo(v_.w) * sc_, bfhi(v_.w) * sc_); \
            *(LAS v4u*)((BUFP) + SD_BT + row_ * SD_XRS + ch_ * 16) = o_; } } while (0)
__device__ __forceinline__ bf16x8_t ssd_tr8(const LAS unsigned char* p, int rs) { const s16x4_t lo = lds_tr16(p), hi = lds_tr16(p + 4 * rs); return (bf16x8_t){lo[0], lo[1], lo[2], lo[3], hi[0], hi[1], hi[2], hi[3]}; }

__device__ __forceinline__ void phase_ssd_s1(const Ctx& C) {
    const bf16* X = WSP(bf16, WS_XBC); const float* DT = WSP(float, WS_DT); float* ACS = WSP(float, WS_ACS); float* ST = WSP(float, WS_ST); const float* alog = INP(19);
#pragma unroll 1
    for (int item = C.bid; item < NB * 32 * 2; item += C.G) {
        int tid = C.tid; asm volatile("" : "+v"(tid));
        const int lane = tid & 63, w = __builtin_amdgcn_readfirstlane(tid >> 6), i16 = lane & 15, kg = lane >> 4;
        const int g = item & 1, c = (item >> 1) & 31, b = item >> 6;
        const size_t tok0 = (size_t)b * SEQ + c * 256;
        LAS float* acsL = (LAS float*)(C.lds + SD_ACS); LAS float* wL = (LAS float*)(C.lds + SD_W);
        if (w < 4) {
            const int h = 4 * g + w; const float Ah = -__expf(alog[h]);
            float d[4], p[4];
#pragma unroll
            for (int i = 0; i < 4; ++i) d[i] = DT[(tok0 + 4 * lane + i) * 8 + h];
            p[0] = d[0] * Ah; p[1] = p[0] + d[1] * Ah; p[2] = p[1] + d[2] * Ah; p[3] = p[2] + d[3] * Ah;
            float run = p[3];
#pragma unroll
            for (int off = 1; off < 64; off <<= 1) { const float up = __builtin_bit_cast(float, __builtin_amdgcn_ds_bpermute(((lane - off) & 63) << 2, __builtin_bit_cast(int, run))); run += (lane >= off) ? up : 0.f; }
            const float excl = run - p[3];
            const float last = __builtin_bit_cast(float, __builtin_amdgcn_readlane(__builtin_bit_cast(int, run), 63));
#pragma unroll
            for (int i = 0; i < 4; ++i) { const float a = excl + p[i]; acsL[w * 256 + 4 * lane + i] = a; ACS[(tok0 + 4 * lane + i) * 8 + h] = a; wL[w * 256 + 4 * lane + i] = d[i] * __expf(last - a); }
        }
        __syncthreads();
        const int hh = w >> 1, nh = w & 1;
        f32x4 acc[4][4];
#pragma unroll
        for (int pt = 0; pt < 4; ++pt)
#pragma unroll
            for (int nt = 0; nt < 4; ++nt) acc[pt][nt] = (f32x4){0.f, 0.f, 0.f, 0.f};
        v4u breg[2], xreg[4];
        SSD_LOAD_TILE(0);
        SSD_STORE_TILE(0, C.lds + SD_TILES, wL);
        __syncthreads();
#pragma unroll 1
        for (int lt = 0; lt < 4; ++lt) {
            if (lt < 3) SSD_LOAD_TILE(lt + 1);
            const LAS unsigned char* Bt = C.lds + SD_TILES + (lt & 1) * SD_BUF; const LAS unsigned char* Xt = Bt + SD_BT;
#pragma unroll
            for (int ks = 0; ks < 2; ++ks) {
                bf16x8_t af[4], bfr[4];
                const int row = 32 * ks + 8 * kg + (i16 >> 2);
#pragma unroll
                for (int pt = 0; pt < 4; ++pt) af[pt] = ssd_tr8(Xt + row * SD_XRS + (hh * 64 + 16 * pt + 4 * (i16 & 3)) * 2, SD_XRS);
#pragma unroll
                for (int nt = 0; nt < 4; ++nt) bfr[nt] = ssd_tr8(Bt + row * SD_BRS + (64 * nh + 16 * nt + 4 * (i16 & 3)) * 2, SD_BRS);
#pragma unroll
                for (int pt = 0; pt < 4; ++pt)
#pragma unroll
                    for (int nt = 0; nt < 4; ++nt) acc[pt][nt] = __builtin_amdgcn_mfma_f32_16x16x32_bf16(af[pt], bfr[nt], acc[pt][nt], 0, 0, 0);
            }
            if (lt < 3) SSD_STORE_TILE(lt + 1, C.lds + SD_TILES + ((lt + 1) & 1) * SD_BUF, wL);
            __syncthreads();
        }
        float* st = ST + (((size_t)(b * 32 + c) * 8 + 4 * g + hh) * 64) * 128;
#pragma unroll
        for (int pt = 0; pt < 4; ++pt)
#pragma unroll
            for (int nt = 0; nt < 4; ++nt)
#pragma unroll
                for (int r = 0; r < 4; ++r) st[(16 * pt + 4 * kg + r) * 128 + 64 * nh + 16 * nt + i16] = acc[pt][nt][r];
    }
}

__device__ __forceinline__ void phase_ssd_s3(const Ctx& C) {
    const bf16* X = WSP(bf16, WS_XBC); const bf16* P = WSP(bf16, WS_PROJ); const float* DT = WSP(float, WS_DT); const float* ACS = WSP(float, WS_ACS); const float* ST = WSP(float, WS_ST);
    bf16* MIXIN = WSP(bf16, WS_MIXIN); const float* Dsk = INP(20); const float* ng = INP(21);
#pragma unroll 1
    for (int item = C.bid; item < NB * 32 * 2; item += C.G) {
        int tid = C.tid; asm volatile("" : "+v"(tid));
        const int lane = tid & 63, w = __builtin_amdgcn_readfirstlane(tid >> 6), i16 = lane & 15, kg = lane >> 4;
        const int g = item & 1, c = (item >> 1) & 31, b = item >> 6;
        const size_t tok0 = (size_t)b * SEQ + c * 256;
        LAS float* acsL = (LAS float*)(C.lds + SD_ACS); LAS float* dtL = (LAS float*)(C.lds + SD_DT);
        for (int e = tid; e < 1024; e += 512) { const int hh = e >> 8, l = e & 255; acsL[e] = ACS[(tok0 + l) * 8 + 4 * g + hh]; dtL[e] = DT[(tok0 + l) * 8 + 4 * g + hh]; }
        __syncthreads();
#pragma unroll 1
        for (int pass = 0; pass < 2; ++pass) {
            const int j = pass ? 15 - w : w, l = 16 * j + i16, stmax = j >> 2;
            bf16x8_t cf[4];
#pragma unroll
            for (int ks = 0; ks < 4; ++ks) cf[ks] = *(const bf16x8_t*)(X + (tok0 + l) * 1024 + 768 + g * 128 + 32 * ks + 8 * kg);
            float al[4];
#pragma unroll
            for (int hh = 0; hh < 4; ++hh) al[hh] = acsL[hh * 256 + l];
            f32x4 O[4][4];
#pragma unroll
            for (int hh = 0; hh < 4; ++hh) {
                const float* pv = ST + (((size_t)(b * 32 + c) * 8 + 4 * g + hh) * 64) * 128; const float el = __expf(al[hh]);
#pragma unroll
                for (int dt = 0; dt < 4; ++dt) {
                    f32x4 a = {0.f, 0.f, 0.f, 0.f};
#pragma unroll
                    for (int ks = 0; ks < 4; ++ks) { const float* pp = pv + (16 * dt + i16) * 128 + 32 * ks + 8 * kg; const f32x4 p0 = *(const f32x4*)pp, p1 = *(const f32x4*)(pp + 4);
                        v4u u; u.x = cvtpk(p0[0], p0[1]); u.y = cvtpk(p0[2], p0[3]); u.z = cvtpk(p1[0], p1[1]); u.w = cvtpk(p1[2], p1[3]);
                        a = __builtin_amdgcn_mfma_f32_16x16x32_bf16(__builtin_bit_cast(bf16x8_t, u), cf[ks], a, 0, 0, 0); }
                    O[hh][dt] = a * el;
                }
            }
            v4u breg[2], xreg[4];
            SSD_LOAD_TILE(0);
            SSD_STORE_TILE(0, C.lds + SD_TILES, dtL);
            __syncthreads();
#pragma unroll 1
            for (int st = 0; st < 4; ++st) {
                if (st < 3) SSD_LOAD_TILE(st + 1);
                const LAS unsigned char* Bt = C.lds + SD_TILES + (st & 1) * SD_BUF; const LAS unsigned char* Xt = Bt + SD_BT;
                if (st <= stmax) {
                    f32x4 s[4];
#pragma unroll
                    for (int rt = 0; rt < 4; ++rt) { f32x4 a = {0.f, 0.f, 0.f, 0.f};
#pragma unroll
                        for (int ks = 0; ks < 4; ++ks) { const bf16x8_t bfr = *(const LAS bf16x8_t*)(Bt + (16 * rt + i16) * SD_BRS + 64 * ks + 16 * kg); a = __builtin_amdgcn_mfma_f32_16x16x32_bf16(bfr, cf[ks], a, 0, 0, 0); }
                        s[rt] = a; }
#pragma unroll
                    for (int hh = 0; hh < 4; ++hh) {
                        bf16x8_t pf[2];
#pragma unroll
                        for (int ks = 0; ks < 2; ++ks) { float pv[8];
#pragma unroll
                            for (int q = 0; q < 2; ++q)
#pragma unroll
                                for (int r = 0; r < 4; ++r) { const int sl = 64 * st + 16 * (2 * ks + q) + 4 * kg + r; pv[4 * q + r] = (sl <= l) ? s[2 * ks + q][r] * __expf(al[hh] - acsL[hh * 256 + sl]) : 0.f; }
                            v4u u; u.x = cvtpk(pv[0], pv[1]); u.y = cvtpk(pv[2], pv[3]); u.z = cvtpk(pv[4], pv[5]); u.w = cvtpk(pv[6], pv[7]); pf[ks] = __builtin_bit_cast(bf16x8_t, u); }
#pragma unroll
                        for (int dt = 0; dt < 4; ++dt)
#pragma unroll
                            for (int ks = 0; ks < 2; ++ks) {
                                const LAS unsigned char* xa = Xt + (32 * ks + 4 * kg + (i16 >> 2)) * SD_XRS + (hh * 64 + 16 * dt + 4 * (i16 & 3)) * 2;
                                const s16x4_t lo = lds_tr16(xa), hi = lds_tr16(xa + 16 * SD_XRS);
                                const bf16x8_t xf = {lo[0], lo[1], lo[2], lo[3], hi[0], hi[1], hi[2], hi[3]};
                                O[hh][dt] = __builtin_amdgcn_mfma_f32_16x16x32_bf16(xf, pf[ks], O[hh][dt], 0, 0, 0);
                            }
                    }
                }
                if (st < 3) SSD_STORE_TILE(st + 1, C.lds + SD_TILES + ((st + 1) & 1) * SD_BUF, dtL);
                __syncthreads();
            }
            float ss = 0.f;
#pragma unroll
            for (int hh = 0; hh < 4; ++hh) { const float Dh = Dsk[4 * g + hh];
#pragma unroll
                for (int dt = 0; dt < 4; ++dt) { const int ch = hh * 64 + 16 * dt + 4 * kg;
                    const v2u xv = *(const v2u*)(X + (tok0 + l) * 1024 + g * 256 + ch), zv = *(const v2u*)(P + (tok0 + l) * HY_NP + C_Z + g * 256 + ch);
                    f32x4 y = O[hh][dt];
                    y[0] = (y[0] + Dh * bflo(xv.x)) * siluf(bflo(zv.x)); y[1] = (y[1] + Dh * bfhi(xv.x)) * siluf(bfhi(zv.x));
                    y[2] = (y[2] + Dh * bflo(xv.y)) * siluf(bflo(zv.y)); y[3] = (y[3] + Dh * bfhi(xv.y)) * siluf(bfhi(zv.y));
                    O[hh][dt] = y; ss += (y[0] * y[0] + y[1] * y[1]) + (y[2] * y[2] + y[3] * y[3]); } }
            ss = x32_sum(x16_sum(ss));
            const float rs = 1.f / sqrtf(ss * (1.f / 256.f) + NORM_EPS);
#pragma unroll
            for (int hh = 0; hh < 4; ++hh)
#pragma unroll
                for (int dt = 0; dt < 4; ++dt) { const int ch = hh * 64 + 16 * dt + 4 * kg; const f32x4 gg = *(const f32x4*)(ng + g * 256 + ch); const f32x4 y = O[hh][dt];
                    v2u o; o.x = cvtpk(y[0] * rs * gg[0], y[1] * rs * gg[1]); o.y = cvtpk(y[2] * rs * gg[2], y[3] * rs * gg[3]);
                    *(v2u*)(MIXIN + (tok0 + l) * 1024 + 512 + g * 256 + ch) = o; }
        }
        __syncthreads();
    }
}
constexpr int GS_RS = 272;
constexpr int GS_KS = 0, GS_VS = 64 * GS_RS, GS_A = 2 * 64 * GS_RS, GS_TB = GS_A + 64 * 272, GS_TBE = GS_TB + 64 * 144, GS_SM = GS_TBE + 64 * 144;
constexpr int GS_HALF = GS_SM + 4 * 64 * 4;
static_assert(2 * GS_HALF <= MISC_OFF, "gdn scan LDS");
constexpr size_t GD_W_ITEM = 64 * 128, GD_UT_ITEM = 128 * 64, GD_AQK_ITEM = 64 * 64;

__device__ __forceinline__ void phase_gdn_scan(const Ctx& C) {
    const bf16* QN = WSP(bf16, WS_QN); const bf16* KN = WSP(bf16, WS_KN); const bf16* VN = WSP(bf16, WS_VN); const float* BETA = WSP(float, WS_BETA); const float* GG = WSP(float, WS_G);
    bf16* Wg = WSP(bf16, WS_GW); bf16* UTg = WSP(bf16, WS_GUT); bf16* AQKg = WSP(bf16, WS_GAQK); float* EGg = WSP(float, WS_GEG); float* EGLg = WSP(float, WS_GEGL); float* GLg = WSP(float, WS_GGL);
#pragma unroll 1
    for (int pair = C.bid; pair < 2048; pair += C.G) {
        int tid = C.tid; asm volatile("" : "+v"(tid));
        const int half = __builtin_amdgcn_readfirstlane(tid >> 8), ht = tid & 255, lane = tid & 63, wq = __builtin_amdgcn_readfirstlane((tid >> 6) & 3), i16 = lane & 15, kg = lane >> 4;
        const int item = pair * 2 + half, n = item & 127, h = (item >> 7) & 7, b = item >> 10;
        const size_t tok0 = (size_t)b * SEQ + n * 64;
        LAS unsigned char* L = C.lds + half * GS_HALF;
        LAS float* A = (LAS float*)(L + GS_A); LAS float* sm = (LAS float*)(L + GS_SM);
#pragma unroll
        for (int r = 0; r < 4; ++r) { const int e = ht + 256 * r, row = e >> 4, ch = e & 15;
            *(LAS v4u*)(L + GS_KS + row * GS_RS + ch * 16) = *(const v4u*)(KN + (tok0 + row) * 1024 + h * 128 + ch * 8);
            *(LAS v4u*)(L + GS_VS + row * GS_RS + ch * 16) = *(const v4u*)(VN + (tok0 + row) * 1024 + h * 128 + ch * 8); }
        if (wq == 0) {
            const float gv = GG[(tok0 + lane) * 8 + h];
            sm[lane] = gv; LDS_WAIT();
            float s = 0.f;
            for (int j = 0; j < 64; ++j) { const float x = sm[j]; s += (j <= lane) ? x : 0.f; }
            LDS_WAIT();
            sm[lane] = s; LDS_WAIT();
            const float gl = sm[63], eg = __expf(s), egl = __expf(gl - s);
            sm[64 + lane] = eg; sm[128 + lane] = egl; sm[192 + lane] = BETA[(tok0 + lane) * 8 + h];
            EGg[(size_t)item * 64 + lane] = eg; EGLg[(size_t)item * 64 + lane] = egl; if (lane == 0) GLg[item] = __expf(gl);
        }
        __syncthreads();
        { const int ct = wq, c = 16 * ct + i16;
          bf16x8_t kb[4], qb[4];
#pragma unroll
          for (int ks = 0; ks < 4; ++ks) { kb[ks] = *(const LAS bf16x8_t*)(L + GS_KS + c * GS_RS + 64 * ks + 16 * kg); qb[ks] = *(const bf16x8_t*)(QN + (tok0 + c) * 1024 + h * 128 + 32 * ks + 8 * kg); }
          const float gc = sm[c], bc = sm[192 + c];
#pragma unroll
          for (int st = 0; st < 4; ++st) {
              bf16* aq = AQKg + (size_t)item * GD_AQK_ITEM + c * 64 + 16 * st + 4 * kg;
              if (st <= ct) {
                  f32x4 aK = {0.f, 0.f, 0.f, 0.f}, aQ = {0.f, 0.f, 0.f, 0.f};
#pragma unroll
                  for (int ks = 0; ks < 4; ++ks) { const bf16x8_t ka = *(const LAS bf16x8_t*)(L + GS_KS + (16 * st + i16) * GS_RS + 64 * ks + 16 * kg);
                      aK = __builtin_amdgcn_mfma_f32_16x16x32_bf16(ka, kb[ks], aK, 0, 0, 0); aQ = __builtin_amdgcn_mfma_f32_16x16x32_bf16(ka, qb[ks], aQ, 0, 0, 0); }
                  f32x4 av; float qv[4];
#pragma unroll
                  for (int r = 0; r < 4; ++r) { const int s = 16 * st + 4 * kg + r; const float dec = __expf(gc - sm[s]); av[r] = (s < c) ? bc * aK[r] * dec : 0.f; qv[r] = (s <= c) ? aQ[r] * dec : 0.f; }
                  *(LAS f32x4*)(A + c * 68 + 16 * st + 4 * kg) = av;
                  v2u w2; w2.x = cvtpk(qv[0], qv[1]); w2.y = cvtpk(qv[2], qv[3]); *(v2u*)aq = w2;
              } else { v2u z; z.x = 0u; z.y = 0u; *(v2u*)aq = z; }
          } }
        __syncthreads();
        if (wq == 0) {
            const int c = lane;
            float t[64];
#pragma unroll
            for (int i = 0; i < 64; ++i) {
                float a0 = (i == c) ? 1.f : 0.f, a1 = 0.f, a2 = 0.f, a3 = 0.f;
#pragma unroll
                for (int j4 = 0; j4 < (i + 3) / 4; ++j4) { const f32x4 av = *(const LAS f32x4*)(A + i * 68 + 4 * j4);
                    if (4 * j4 + 0 < i) a0 -= av[0] * t[4 * j4 + 0];
                    if (4 * j4 + 1 < i) a1 -= av[1] * t[4 * j4 + 1];
                    if (4 * j4 + 2 < i) a2 -= av[2] * t[4 * j4 + 2];
                    if (4 * j4 + 3 < i) a3 -= av[3] * t[4 * j4 + 3]; }
                t[i] = (a0 + a1) + (a2 + a3);
            }
            const float bc = sm[192 + c], be = bc * sm[64 + c];
            LAS bf16* Tb = (LAS bf16*)(L + GS_TB); LAS bf16* Tbe = (LAS bf16*)(L + GS_TBE);
#pragma unroll
            for (int i = 0; i < 64; ++i) { Tb[i * 72 + c] = (bf16)f2bf(t[i] * bc); Tbe[i * 72 + c] = (bf16)f2bf(t[i] * be); }
        }
        __syncthreads();
#pragma unroll
        for (int x = 0; x < 2; ++x) {
            const int et = 2 * wq + x;
            bf16x8_t vb[2], ka2[2];
#pragma unroll
            for (int ks = 0; ks < 2; ++ks) {
                const LAS unsigned char* va = L + GS_VS + (32 * ks + 8 * kg + (i16 >> 2)) * GS_RS + (16 * et + 4 * (i16 & 3)) * 2;
                const s16x4_t lo = lds_tr16(va), hi = lds_tr16(va + 4 * GS_RS);
                vb[ks] = (bf16x8_t){lo[0], lo[1], lo[2], lo[3], hi[0], hi[1], hi[2], hi[3]};
                const LAS unsigned char* kaa = L + GS_KS + (32 * ks + 8 * kg + (i16 >> 2)) * GS_RS + (16 * et + 4 * (i16 & 3)) * 2;
                const s16x4_t lo2 = lds_tr16(kaa), hi2 = lds_tr16(kaa + 4 * GS_RS);
                ka2[ks] = (bf16x8_t){lo2[0], lo2[1], lo2[2], lo2[3], hi2[0], hi2[1], hi2[2], hi2[3]};
            }
#pragma unroll
            for (int ct = 0; ct < 4; ++ct) {
                f32x4 au = {0.f, 0.f, 0.f, 0.f}, aw = {0.f, 0.f, 0.f, 0.f};
#pragma unroll
                for (int ks = 0; ks < 2; ++ks) {
                    const bf16x8_t tb = *(const LAS bf16x8_t*)(L + GS_TB + (16 * ct + i16) * 144 + 64 * ks + 16 * kg);
                    const bf16x8_t tbe = *(const LAS bf16x8_t*)(L + GS_TBE + (16 * ct + i16) * 144 + 64 * ks + 16 * kg);
                    au = __builtin_amdgcn_mfma_f32_16x16x32_bf16(tb, vb[ks], au, 0, 0, 0);
                    aw = __builtin_amdgcn_mfma_f32_16x16x32_bf16(ka2[ks], tbe, aw, 0, 0, 0);
                }
                v2u wu; wu.x = cvtpk(au[0], au[1]); wu.y = cvtpk(au[2], au[3]);
                *(v2u*)(UTg + (size_t)item * GD_UT_ITEM + (16 * et + i16) * 64 + 16 * ct + 4 * kg) = wu;
                v2u ww; ww.x = cvtpk(aw[0], aw[1]); ww.y = cvtpk(aw[2], aw[3]);
                *(v2u*)(Wg + (size_t)item * GD_W_ITEM + (16 * ct + i16) * 128 + 16 * et + 4 * kg) = ww;
            }
        }
        __syncthreads();
    }
}

constexpr int GQ_ST = 0, GQ_VT = 16 * 272, GQ_VTG = GQ_VT + 16 * 144, GQ_K = GQ_VTG + 16 * 144, GQ_KT = 64 * 272;
#define GDN_PREFETCH(NN) do { const size_t item_ = (size_t)(b * 8 + h) * 128 + (NN); const size_t tok0_ = (size_t)b * SEQ + (NN) * 64; const int trow_ = 16 * rt + i16; \
            if (!isq) { _Pragma("unroll") for (int ks = 0; ks < 4; ++ks) aw[ks] = *(const bf16x8_t*)(Wg + item_ * GD_W_ITEM + trow_ * 128 + 32 * ks + 8 * kg); \
                ut = *(const v2u*)(UTg + item_ * GD_UT_ITEM + (e0 + i16) * 64 + 16 * rt + 4 * kg); egl4 = *(const f32x4*)(EGLg + item_ * 64 + 16 * rt + 4 * kg); } \
            else { _Pragma("unroll") for (int ks = 0; ks < 4; ++ks) aw[ks] = *(const bf16x8_t*)(QN + (tok0_ + trow_) * 1024 + h * 128 + 32 * ks + 8 * kg); \
                _Pragma("unroll") for (int ks = 0; ks < 2; ++ks) aq[ks] = *(const bf16x8_t*)(AQKg + item_ * GD_AQK_ITEM + trow_ * 64 + 32 * ks + 8 * kg); \
                eg4 = *(const f32x4*)(EGg + item_ * 64 + 16 * rt + 4 * kg); } \
            gl = GLg[item_]; \
            kr0 = *(const v4u*)(KN + (tok0_ + srow) * 1024 + h * 128 + sch * 8); kr1 = *(const v4u*)(KN + (tok0_ + srow) * 1024 + h * 128 + 64 + sch * 8); } while (0)
__device__ __forceinline__ void phase_gdn_seq(const Ctx& C) {
    const bf16* QN = WSP(bf16, WS_QN); const bf16* KN = WSP(bf16, WS_KN);
    const bf16* Wg = WSP(bf16, WS_GW); const bf16* UTg = WSP(bf16, WS_GUT); const bf16* AQKg = WSP(bf16, WS_GAQK); const float* EGg = WSP(float, WS_GEG); const float* EGLg = WSP(float, WS_GEGL); const float* GLg = WSP(float, WS_GGL);
    bf16* O = WSP(bf16, WS_O1);
#pragma unroll 1
    for (int unit = C.bid; unit < 256; unit += C.G) {
        int tid = C.tid; asm volatile("" : "+v"(tid));
        const int lane = tid & 63, wv = __builtin_amdgcn_readfirstlane(tid >> 6), i16 = lane & 15, kg = lane >> 4, rt = wv & 3; const bool isq = wv >= 4;
        const int es = unit & 7, h = (unit >> 3) & 7, b = unit >> 6, e0 = 16 * es;
        LAS unsigned char* L = C.lds;
        const int srow = tid >> 3, sch = tid & 7;
        f32x4 S = {0.f, 0.f, 0.f, 0.f};
        { v2u z; z.x = 0u; z.y = 0u; *(LAS v2u*)(L + GQ_ST + i16 * 272 + (16 * wv + 4 * kg) * 2) = z; }
        bf16x8_t aw[4], aq[2]; v2u ut; f32x4 eg4 = {0.f, 0.f, 0.f, 0.f}, egl4 = {0.f, 0.f, 0.f, 0.f}; float gl; v4u kr0, kr1;
        aq[0] = aq[1] = (bf16x8_t){0, 0, 0, 0, 0, 0, 0, 0}; ut.x = ut.y = 0u;
        GDN_PREFETCH(0);
        { LAS unsigned char* kd = L + GQ_K + srow * 272 + sch * 16; *(LAS v4u*)kd = kr0; *(LAS v4u*)(kd + 128) = kr1; }
#pragma unroll 1
        for (int n = 0; n < 128; ++n) {
            bf16x8_t cw[4], cq[2]; v2u cut = ut; f32x4 ceg = eg4, cegl = egl4; const float cgl = gl;
#pragma unroll
            for (int ks = 0; ks < 4; ++ks) cw[ks] = aw[ks];
            cq[0] = aq[0]; cq[1] = aq[1];
            if (n + 1 < 128) GDN_PREFETCH(n + 1);
            __syncthreads();
            f32x4 acc = {0.f, 0.f, 0.f, 0.f};
#pragma unroll
            for (int ks = 0; ks < 4; ++ks) { const bf16x8_t sb = *(const LAS bf16x8_t*)(L + GQ_ST + i16 * 272 + 64 * ks + 16 * kg); acc = __builtin_amdgcn_mfma_f32_16x16x32_bf16(cw[ks], sb, acc, 0, 0, 0); }
            f32x4 qs = {0.f, 0.f, 0.f, 0.f};
            if (!isq) {
                const float u0 = bflo(cut.x), u1 = bfhi(cut.x), u2 = bflo(cut.y), u3 = bfhi(cut.y);
                const float v0 = u0 - acc[0], v1 = u1 - acc[1], v2 = u2 - acc[2], v3 = u3 - acc[3];
                v2u a; a.x = cvtpk(v0, v1); a.y = cvtpk(v2, v3); *(LAS v2u*)(L + GQ_VT + i16 * 144 + (16 * rt + 4 * kg) * 2) = a;
                v2u g2; g2.x = cvtpk(v0 * cegl[0], v1 * cegl[1]); g2.y = cvtpk(v2 * cegl[2], v3 * cegl[3]); *(LAS v2u*)(L + GQ_VTG + i16 * 144 + (16 * rt + 4 * kg) * 2) = g2;
            } else { qs[0] = acc[0] * ceg[0]; qs[1] = acc[1] * ceg[1]; qs[2] = acc[2] * ceg[2]; qs[3] = acc[3] * ceg[3]; }
            __syncthreads();
            { const LAS unsigned char* Kt = L + GQ_K + (n & 1) * GQ_KT;
              S *= cgl;
#pragma unroll
              for (int ks = 0; ks < 2; ++ks) {
                  const LAS unsigned char* kaa = Kt + (32 * ks + 8 * kg + (i16 >> 2)) * 272 + (16 * wv + 4 * (i16 & 3)) * 2;
                  const s16x4_t lo = lds_tr16(kaa), hi = lds_tr16(kaa + 4 * 272);
                  const bf16x8_t ka = {lo[0], lo[1], lo[2], lo[3], hi[0], hi[1], hi[2], hi[3]};
                  const bf16x8_t vb = *(const LAS bf16x8_t*)(L + GQ_VTG + i16 * 144 + 64 * ks + 16 * kg);
                  S = __builtin_amdgcn_mfma_f32_16x16x32_bf16(ka, vb, S, 0, 0, 0);
              }
              v2u sw; sw.x = cvtpk(S[0], S[1]); sw.y = cvtpk(S[2], S[3]); *(LAS v2u*)(L + GQ_ST + i16 * 272 + (16 * wv + 4 * kg) * 2) = sw; }
            if (isq) {
#pragma unroll
                for (int ks = 0; ks < 2; ++ks) { const bf16x8_t vb = *(const LAS bf16x8_t*)(L + GQ_VT + i16 * 144 + 64 * ks + 16 * kg); qs = __builtin_amdgcn_mfma_f32_16x16x32_bf16(cq[ks], vb, qs, 0, 0, 0); }
                bf16* op = O + ((size_t)b * SEQ + n * 64 + 16 * rt + 4 * kg) * 1024 + h * 128 + e0 + i16;
#pragma unroll
                for (int r = 0; r < 4; ++r) op[(size_t)r * 1024] = (bf16)f2bf(qs[r]);
            }
            if (n + 1 < 128) { LAS unsigned char* kd = L + GQ_K + ((n + 1) & 1) * GQ_KT + srow * 272 + sch * 16; *(LAS v4u*)kd = kr0; *(LAS v4u*)(kd + 128) = kr1; }
        }
        __syncthreads();
    }
}
__device__ __forceinline__ void phase_gdn_gate(const Ctx& C) {
    const bf16* O = WSP(bf16, WS_O1); const bf16* Z = WSP(bf16, WS_Z1); bf16* GIN = WSP(bf16, WS_GIN); const float* ng = INP(26);
    const int gw = C.bid * 8 + C.wave, NGW = C.G * 8, lane = C.lane;
    for (int item = gw; item < NTOK * 8; item += NGW) {
        const size_t off = (size_t)item * 128 + lane * 2;
        const unsigned ou = *(const unsigned*)(O + off); const float o0 = bflo(ou), o1 = bfhi(ou);
        const float rs = 1.f / sqrtf(wave_sum(o0 * o0 + o1 * o1) * (1.f / 128.f) + NORM_EPS);
        const unsigned zu = *(const unsigned*)(Z + off);
        *(unsigned*)(GIN + off) = pk2(o0 * rs * ng[lane * 2] * siluf(bflo(zu)), o1 * rs * ng[lane * 2 + 1] * siluf(bfhi(zu)));
    }
}
__device__ __forceinline__ void unpack8(const v4u v, float (&f)[8]) { f[0] = bflo(v.x); f[1] = bfhi(v.x); f[2] = bflo(v.y); f[3] = bfhi(v.y); f[4] = bflo(v.z); f[5] = bfhi(v.z); f[6] = bflo(v.w); f[7] = bfhi(v.w); }
__device__ __forceinline__ v4u pack8(const float (&f)[8]) { v4u o; o.x = cvtpk(f[0], f[1]); o.y = cvtpk(f[2], f[3]); o.z = cvtpk(f[4], f[5]); o.w = cvtpk(f[6], f[7]); return o; }
__device__ __forceinline__ void load8f(const float* p, float (&f)[8]) { const f32x4 a = *(const f32x4*)p, b = *(const f32x4*)(p + 4); f[0] = a[0]; f[1] = a[1]; f[2] = a[2]; f[3] = a[3]; f[4] = b[0]; f[5] = b[1]; f[6] = b[2]; f[7] = b[3]; }

constexpr int FA_RUN = 32;
__device__ __forceinline__ void phase_ffn_act(const Ctx& C, int layer, int ntok) {
    const bf16* U = WSP(bf16, WS_U); bf16* ACT = WSP(bf16, WS_ACT);
    const float* cw = INP(29) + (size_t)layer * 3 * FF2; const float* cb = INP(30) + (size_t)layer * FF2;
    const int nitems = (ntok / FA_RUN) * (FF / 8);
#pragma unroll 1
    for (int idx = C.bid * 512 + C.tid; idx < nitems; idx += C.G * 512) {
        const int run = idx / (FF / 8), ch = (idx - run * (FF / 8)) * 8, t0 = run * FA_RUN;
        float wg[3][8], wv[3][8], bg[8], bv[8];
#pragma unroll
        for (int j = 0; j < 3; ++j) { load8f(cw + j * FF2 + ch, wg[j]); load8f(cw + j * FF2 + FF + ch, wv[j]); }
        load8f(cb + ch, bg); load8f(cb + FF + ch, bv);
        float g1[8], g2[8], v1[8], v2[8];
        if ((t0 & (SEQ - 1)) == 0) {
#pragma unroll
            for (int i = 0; i < 8; ++i) { g1[i] = g2[i] = v1[i] = v2[i] = 0.f; }
        } else { unpack8(*(const v4u*)(U + (size_t)(t0 - 1) * FF2 + ch), g1); unpack8(*(const v4u*)(U + (size_t)(t0 - 2) * FF2 + ch), g2);
                 unpack8(*(const v4u*)(U + (size_t)(t0 - 1) * FF2 + FF + ch), v1); unpack8(*(const v4u*)(U + (size_t)(t0 - 2) * FF2 + FF + ch), v2); }
#pragma unroll 4
        for (int tt = 0; tt < FA_RUN; ++tt) {
            float g0[8], v0[8], o[8];
            unpack8(*(const v4u*)(U + (size_t)(t0 + tt) * FF2 + ch), g0); unpack8(*(const v4u*)(U + (size_t)(t0 + tt) * FF2 + FF + ch), v0);
#pragma unroll
            for (int i = 0; i < 8; ++i) { const float gg = bg[i] + wg[0][i] * g2[i] + wg[1][i] * g1[i] + wg[2][i] * g0[i]; const float vv = bv[i] + wv[0][i] * v2[i] + wv[1][i] * v1[i] + wv[2][i] * v0[i];
                o[i] = siluf(gg) * vv; g2[i] = g1[i]; g1[i] = g0[i]; v2[i] = v1[i]; v1[i] = v0[i]; }
            *(v4u*)(ACT + (size_t)(t0 + tt) * FF + ch) = pack8(o);
        }
    }
}

constexpr int RC_RUN = 16;
__device__ __forceinline__ void phase_rope_conv(const Ctx& C) {
    bf16* P = WSP(bf16, WS_PROJ); const float* tab = WSP(float, WS_ROPE);
    const int gt = C.bid * 512 + C.tid, NT = C.G * 512;
#pragma unroll 1
    for (int idx = gt; idx < NTOK * 14; idx += NT) {
        const int tok = idx / 14, hd = idx - tok * 14;
        const int col0 = hd < 8 ? hd * 64 : C_KV + ((hd - 8) >> 1) * 256 + ((hd - 8) & 1) * 64;
        bf16* p = P + (size_t)tok * HY_NP + col0;
        float x1[8], x2[8], cs[8], sn[8], o1[8], o2[8];
        unpack8(*(const v4u*)p, x1); unpack8(*(const v4u*)(p + 8), x2); load8f(tab + (size_t)tok * 16, cs); load8f(tab + (size_t)tok * 16 + 8, sn);
#pragma unroll
        for (int i = 0; i < 8; ++i) { o1[i] = x1[i] * cs[i] - x2[i] * sn[i]; o2[i] = x2[i] * cs[i] + x1[i] * sn[i]; }
        *(v4u*)p = pack8(o1); *(v4u*)(p + 8) = pack8(o2);
    }
    { const float* cw = INP(16); const float* cb = INP(17); bf16* X = WSP(bf16, WS_XBC);
#pragma unroll 1
      for (int idx = gt; idx < (NTOK / RC_RUN) * 128; idx += NT) {
          const int run = idx >> 7, ch = (idx & 127) * 8, t0 = run * RC_RUN;
          float w[4][8], bb[8], h1[8], h2[8], h3[8];
#pragma unroll
          for (int j = 0; j < 4; ++j) load8f(cw + j * 1024 + ch, w[j]);
          load8f(cb + ch, bb);
          if ((t0 & (SEQ - 1)) == 0) {
#pragma unroll
              for (int i = 0; i < 8; ++i) { h1[i] = h2[i] = h3[i] = 0.f; }
          } else { unpack8(*(const v4u*)(P + (size_t)(t0 - 1) * HY_NP + C_XBC + ch), h1); unpack8(*(const v4u*)(P + (size_t)(t0 - 2) * HY_NP + C_XBC + ch), h2); unpack8(*(const v4u*)(P + (size_t)(t0 - 3) * HY_NP + C_XBC + ch), h3); }
#pragma unroll 4
          for (int tt = 0; tt < RC_RUN; ++tt) {
              float h0[8], o[8];
              unpack8(*(const v4u*)(P + (size_t)(t0 + tt) * HY_NP + C_XBC + ch), h0);
#pragma unroll
              for (int i = 0; i < 8; ++i) { o[i] = siluf(bb[i] + w[0][i] * h3[i] + w[1][i] * h2[i] + w[2][i] * h1[i] + w[3][i] * h0[i]); h3[i] = h2[i]; h2[i] = h1[i]; h1[i] = h0[i]; }
              *(v4u*)(X + (size_t)(t0 + tt) * 1024 + ch) = pack8(o);
          }
      } }
    { const float* side = WSP(float, WS_SIDE); float* DT = WSP(float, WS_DT); const float* db = INP(18);
      for (int idx = gt; idx < NTOK * 8; idx += NT) { const int tok = idx >> 3, h = idx & 7; DT[idx] = softplusf(side[(size_t)tok * 32 + 24 + h] + db[h]); } }
}

constexpr int GP_RUN = 16;
__device__ __forceinline__ void phase_gdn_prep(const Ctx& C) {
    const bf16* QKV = WSP(bf16, WS_QKV); const float* cw = INP(23);
    bf16* QN = WSP(bf16, WS_QN); bf16* KN = WSP(bf16, WS_KN); bf16* VN = WSP(bf16, WS_VN);
    const int gt = C.bid * 512 + C.tid, NT = C.G * 512;
#pragma unroll 1
    for (int idx = gt; idx < (NTOK / GP_RUN) * 384; idx += NT) {
        const int run = idx / 384, cc = idx - run * 384, ch = cc * 8, which = cc >> 7, t0 = run * GP_RUN;
        float w[4][8], h1[8], h2[8], h3[8];
#pragma unroll
        for (int j = 0; j < 4; ++j) load8f(cw + j * 3072 + ch, w[j]);
        if ((t0 & (SEQ - 1)) == 0) {
#pragma unroll
            for (int i = 0; i < 8; ++i) { h1[i] = h2[i] = h3[i] = 0.f; }
        } else { unpack8(*(const v4u*)(QKV + (size_t)(t0 - 1) * 3072 + ch), h1); unpack8(*(const v4u*)(QKV + (size_t)(t0 - 2) * 3072 + ch), h2); unpack8(*(const v4u*)(QKV + (size_t)(t0 - 3) * 3072 + ch), h3); }
        bf16* dst = (which == 0 ? QN : (which == 1 ? KN : VN)) + (ch & 1023);
        const float qs = which == 0 ? 0.08838834764831845f : 1.f;
#pragma unroll 2
        for (int tt = 0; tt < GP_RUN; ++tt) {
            float h0[8], o[8]; float ss = 0.f;
            unpack8(*(const v4u*)(QKV + (size_t)(t0 + tt) * 3072 + ch), h0);
#pragma unroll
            for (int i = 0; i < 8; ++i) { o[i] = siluf(w[0][i] * h3[i] + w[1][i] * h2[i] + w[2][i] * h1[i] + w[3][i] * h0[i]); ss += o[i] * o[i]; h3[i] = h2[i]; h2[i] = h1[i]; h1[i] = h0[i]; }
            ss = row_sum16(ss);
            const float rs = which < 2 ? qs / sqrtf(ss + NORM_EPS) : 1.f;
#pragma unroll
            for (int i = 0; i < 8; ++i) o[i] *= rs;
            *(v4u*)(dst + (size_t)(t0 + tt) * 1024) = pack8(o);
        }
    }
    { const float* side = WSP(float, WS_SIDE2); float* BETA = WSP(float, WS_BETA); float* GG = WSP(float, WS_G); const float* db = INP(24); const float* al = INP(25);
      for (int idx = gt; idx < NTOK * 8; idx += NT) { const int tok = idx >> 3, h = idx & 7;
          BETA[idx] = sigmf(side[(size_t)tok * 16 + h]); GG[idx] = -__expf(al[h]) * softplusf(side[(size_t)tok * 16 + 8 + h] + db[h]); } }
}
constexpr int N_PHASES = 47;
#ifndef PHMASK
#define PHMASK 0xFFFFFFFFFFFFFFFFull
#endif
#define EN(k) (((PHMASK) >> (k)) & 1ull)
#ifndef REP_PH
#define REP_PH (-1)
#endif

__global__ void __launch_bounds__(512, 2) mega_fwd(Args args) {
    extern __shared__ __attribute__((aligned(16))) unsigned char lds_raw[];
    XcdBarrier bar;
    Ctx C0;
    C0.lds = (LAS unsigned char*)lds_raw;
    C0.tid = threadIdx.x; C0.lane = C0.tid & 63; C0.wave = __builtin_amdgcn_readfirstlane(C0.tid >> 6); C0.G = gridDim.x; C0.bid = blockIdx.x;
    { const Ctx& C = C0;
    volatile LAS unsigned* MISC = (volatile LAS unsigned*)(C.lds + MISC_OFF);
    if (C.tid < 16) MISC[C.tid] = 0u;
    if (C.tid == 0) { LAS unsigned long long* pt = (LAS unsigned long long*)(C.lds + PTR_OFF);
#pragma unroll
        for (int i = 0; i < 32; ++i) pt[i] = (unsigned long long)args.in[i];
        pt[32] = (unsigned long long)args.out; pt[33] = (unsigned long long)args.ws;
        LAS float* fq = (LAS float*)(C.lds + PTR_OFF + 34 * 8);
#pragma unroll
        for (int i = 0; i < 8; ++i) fq[i] = args.ifq.f[i]; }
    __syncthreads();
    gu32* ctl = (gu32*)(ldptr(C, 33) + WS_CTL);
    bar.bar = (unsigned*)(ctl + CW_BAR); bar.x = 0; bar.st = nullptr;
    const bool multi = (args.ph_hi - args.ph_lo) > 1;
    if (multi) bar = xcd_barrier_post((unsigned*)(ctl + CW_BAR), MISC + 8);
    if (multi) { cooperative_groups::this_grid().sync(); }
    }

    const int ph_lo = args.ph_lo, ph_hi = args.ph_hi;
#define MKCTX Ctx C; { int tid = threadIdx.x, bid = blockIdx.x, G = gridDim.x; asm volatile("" : "+v"(tid)); asm volatile("" : "+s"(bid)); asm volatile("" : "+s"(G)); \
                 C.lds = (LAS unsigned char*)lds_raw; C.tid = tid; C.lane = tid & 63; C.wave = __builtin_amdgcn_readfirstlane(tid >> 6); C.G = G; C.bid = bid; }
#define PH(k, BODY) if (EN(k) && ph_lo <= (k) && (k) < ph_hi) { { MKCTX BODY } if (REP_PH == (k)) { xcd_barrier(bar); { MKCTX BODY } } if ((k) != 46 && ph_hi - ph_lo > 1) xcd_barrier(bar); }
#define GEMM_CALL(EPI, A_, B_, M_, N_, K_, EINIT) { pg8::Gemm g{A_, B_, M_, N_, K_}; pg8::StaticOrder S; S.init(M_, N_, C.G, C.bid); EPI E EINIT; pg8::gemm_phase<EPI, pg8::StaticOrder, true, true>(C.lds, g, S, E, C.tid); }
    PH(0, phase_prologue(C);)
    PH(1, GEMM_CALL(EpiHyIn, WSP(bf16, WS_HN), WSP(bf16, WS_W_HYIN), NTOK, HY_NP, DM, ({WSP(bf16, WS_PROJ), WSP(float, WS_SIDE)})))
    PH(2, phase_rope_conv(C);)
    PH(3, phase_compress(C); phase_ssd_s1(C);)
    PH(4, phase_ssd_s2(C);)
    PH(5, phase_ssd_s3(C);)
    PH(6, phase_nsa(C);)
    PH(7, GEMM_CALL(EpiF32, WSP(bf16, WS_MIXIN), WSP(bf16, WS_W_HYOUT), NTOK, DM, DM, ({WSP(float, WS_MIX), DM})))
    PH(8, phase_res(C, INP(0), OUTP(), WSP(float, WS_MIX), 0, NTOK, INP(3), INP(4), WSP(bf16, WS_HN));)
#define FFN_STEP(LAYER, K) { MKCTX const int hb = (K) >> 2, step = (K) & 3; \
        if (step == 0) GEMM_CALL(EpiB16, WSP(bf16, WS_HN) + (size_t)hb * FH * DM, ((LAYER) ? WSP(bf16, WS_W_UP1) : WSP(bf16, WS_W_UP0)), FH, FF2, DM, ({WSP(bf16, WS_U), FF2})) \
        else if (step == 1) phase_ffn_act(C, (LAYER), FH); \
        else if (step == 2) GEMM_CALL(EpiF32, WSP(bf16, WS_ACT), ((LAYER) ? WSP(bf16, WS_W_DN1) : WSP(bf16, WS_W_DN0)), FH, DM, FF, ({WSP(float, WS_F), DM})) \
        else phase_res(C, OUTP(), OUTP(), WSP(float, WS_F), hb * FH, FH, INP(5) + (LAYER) * DM, (LAYER) ? (const float*)nullptr : INP(2) + DM, WSP(bf16, WS_HN)); }
#define FFN_LAYER(LAYER) if (EN(9) && ph_lo <= 9 && 9 < ph_hi) { _Pragma("unroll 1") for (int k = 0; k < 8; ++k) { FFN_STEP(LAYER, k) \
        if (REP_PH >= 100 && (k & 3) == REP_PH - 100) { xcd_barrier(bar); FFN_STEP(LAYER, k) } \
        if (!((LAYER) == 1 && k == 7)) xcd_barrier(bar); } }
    FFN_LAYER(0)
    PH(25, GEMM_CALL(EpiGdnIn, WSP(bf16, WS_HN), WSP(bf16, WS_W_GDNIN), NTOK, GDN_NP, DM, ({WSP(bf16, WS_QKV), WSP(bf16, WS_Z1), WSP(float, WS_SIDE2)})))
    PH(26, phase_gdn_prep(C);)
    PH(27, phase_gdn_scan(C);)
    PH(47, phase_gdn_seq(C);)
    PH(28, phase_gdn_gate(C);)
    PH(29, GEMM_CALL(EpiF32, WSP(bf16, WS_GIN), WSP(bf16, WS_W_GDNOUT), NTOK, DM, DM, ({WSP(float, WS_MIX1), DM})))
    PH(30, phase_res(C, OUTP(), OUTP(), WSP(float, WS_MIX1), 0, NTOK, INP(3) + DM, INP(4) + DM, WSP(bf16, WS_HN));)
    FFN_LAYER(1)
}

extern "C" void kernel_launch(void* const* d_in, const int* in_sizes, int n_in, void* d_out, int out_size, void* d_ws, size_t ws_size, hipStream_t stream) {
    static int grid = 0;
    if (grid == 0) {
        if (n_in != 32 || in_sizes[0] != NTOK * DM || out_size != NTOK * DM || ws_size < WS_END) {
            fprintf(stderr, "kernel_launch: unexpected shapes: n_in %d in0 %d out %d ws %zu (need %zu); nothing launched\n", n_in, n_in > 0 ? in_sizes[0] : -1, out_size, ws_size, (size_t)WS_END); grid = -1; return; }
        int dev = 0, cus = 0, per_cu = 0;
        if (hipGetDevice(&dev) != hipSuccess || hipDeviceGetAttribute(&cus, hipDeviceAttributeMultiprocessorCount, dev) != hipSuccess) { grid = -1; return; }
        if (hipFuncSetAttribute((const void*)mega_fwd, hipFuncAttributeMaxDynamicSharedMemorySize, LDS_BYTES) != hipSuccess) { fprintf(stderr, "kernel_launch: hipFuncSetAttribute failed\n"); grid = -1; return; }
        if (hipOccupancyMaxActiveBlocksPerMultiprocessor(&per_cu, (const void*)mega_fwd, 512, LDS_BYTES) != hipSuccess || per_cu < 1) { fprintf(stderr, "kernel_launch: occupancy query says %d blocks per CU\n", per_cu); (void)hipGetLastError(); grid = -1; return; }
        grid = cus;
    }
    if (grid < 0) return;
    if (hipMemsetAsync((char*)d_ws + WS_CTL, 0, CTL_ZERO_BYTES, stream) != hipSuccess) { fprintf(stderr, "kernel_launch: memset failed\n"); return; }
    Args a{};
    for (int i = 0; i < 32; ++i) a.in[i] = (const float*)d_in[i];
    a.out = (float*)d_out; a.ws = (unsigned char*)d_ws;
    for (int i = 0; i < 8; ++i) a.ifq.f[i] = (float)pow(500000.0, -(double)(2 * i) / 16.0);
#if MK_ONE_LAUNCH
    a.ph_lo = 0; a.ph_hi = 100;
    void* kargs[] = {&a};
    hipError_t e = hipLaunchCooperativeKernel((const void*)mega_fwd, dim3(grid), dim3(512), kargs, LDS_BYTES, stream);
    if (e != hipSuccess) fprintf(stderr, "kernel_launch: cooperative launch failed: %s (grid %d)\n", hipGetErrorString(e), grid);
#else
    for (int ph = 0; ph < N_PHASES; ++ph) { a.ph_lo = ph; a.ph_hi = ph + 1; hipLaunchKernelGGL(mega_fwd, dim3(grid), dim3(512), LDS_BYTES, stream, a); }
#endif
}
```
